# Optimizing an MI355X kernel written in HIP

```python
import math
import jax, jax.numpy as jnp
from jax import lax
import numpy as np

D_MODEL = 1024
BATCH = 8
SEQ = 2048
DEPTH = 4

CHUNK = 64
N_MEM = 256
N_A_LAYERS = DEPTH // 2
N_B_LAYERS = DEPTH - N_A_LAYERS
MEM_HEADS = 4
MEM_HEAD_DIM = 64
MEM_WIDTH = MEM_HEADS * MEM_HEAD_DIM
TOK_WIDTH = D_MODEL - MEM_WIDTH
SSM_GROUP = 16
SSM_GROUPS = TOK_WIDTH // SSM_GROUP
SSM_STATE = 64
DIFF_HEAD_DIM = 64
DIFF_HEADS = TOK_WIDTH // (2 * DIFF_HEAD_DIM)
DIFF_V_DIM = 2 * DIFF_HEAD_DIM
D_FF = ((math.ceil(8 * D_MODEL / 3) + 255) // 256) * 256
Q_BLOCK = 128
EPS = 1e-6
DT_MIN = 0.001
DT_MAX = 0.1

kernel_name = "hybrid_s5_diffattn_yoco_encoder"


def rms_norm(x, g):
    xf = x.astype(jnp.float32)
    y = xf * lax.rsqrt(jnp.mean(xf * xf, axis=-1, keepdims=True) + EPS)
    return (y * g.astype(jnp.float32)).astype(x.dtype)


def s5_mixer(u, a_re, a_im, log_dt, b_re, b_im, c_re, c_im, d_skip, w_glu):
    bsz, L, _ = u.shape
    f32 = jnp.float32
    uf = u.astype(f32).reshape(bsz, L, SSM_GROUPS, SSM_GROUP)
    a_re = a_re.astype(f32); a_im = a_im.astype(f32)
    dt = jnp.exp(log_dt.astype(f32))[:, None]
    mag = jnp.exp(dt * a_re)
    abar_re = mag * jnp.cos(dt * a_im)
    abar_im = mag * jnp.sin(dt * a_im)
    den = a_re * a_re + a_im * a_im
    nr = abar_re - 1.0
    coef_re = (nr * a_re + abar_im * a_im) / den
    coef_im = (abar_im * a_re - nr * a_im) / den
    b_re = b_re.astype(f32); b_im = b_im.astype(f32)
    bbar_re = coef_re[..., None] * b_re - coef_im[..., None] * b_im
    bbar_im = coef_re[..., None] * b_im + coef_im[..., None] * b_re
    bu_re = jnp.einsum('blgp,gnp->blgn', uf, bbar_re)
    bu_im = jnp.einsum('blgp,gnp->blgn', uf, bbar_im)
    a_seq_re = jnp.broadcast_to(abar_re, (1, L, SSM_GROUPS, SSM_STATE))
    a_seq_im = jnp.broadcast_to(abar_im, (1, L, SSM_GROUPS, SSM_STATE))

    def combine(left, right):
        al_re, al_im, bl_re, bl_im = left
        ar_re, ar_im, br_re, br_im = right
        return (al_re * ar_re - al_im * ar_im,
                al_re * ar_im + al_im * ar_re,
                ar_re * bl_re - ar_im * bl_im + br_re,
                ar_re * bl_im + ar_im * bl_re + br_im)

    _, _, s_re, s_im = lax.associative_scan(combine, (a_seq_re, a_seq_im, bu_re, bu_im), axis=1)
    y = (jnp.einsum('blgn,gpn->blgp', s_re, c_re.astype(f32))
         - jnp.einsum('blgn,gpn->blgp', s_im, c_im.astype(f32)))
    y = y.reshape(bsz, L, TOK_WIDTH) + d_skip.astype(f32) * uf.reshape(bsz, L, TOK_WIDTH)
    h = jax.nn.gelu(y).astype(u.dtype)
    return h * jax.nn.sigmoid(h @ w_glu)


def memory_attention(q, mem_n, wk, wv, q_g, k_g):
    bsz, L, _ = q.shape
    M = mem_n.shape[1]
    qh = rms_norm(q.reshape(bsz, L, MEM_HEADS, MEM_HEAD_DIM), q_g)
    kh = rms_norm((mem_n @ wk).reshape(bsz, M, MEM_HEADS, MEM_HEAD_DIM), k_g)
    vh = (mem_n @ wv).reshape(bsz, M, MEM_HEADS, MEM_HEAD_DIM)
    s = jnp.einsum('blhd,bmhd->bhlm', qh, kh).astype(jnp.float32) * (MEM_HEAD_DIM ** -0.5)
    p = jax.nn.softmax(s, axis=-1)
    o = jnp.einsum('bhlm,bmhd->blhd', p.astype(vh.dtype), vh)
    return o.reshape(bsz, L, MEM_WIDTH)


def diff_attention(q, k, v, lam, sub_g, lambda_init):
    bsz, L = q.shape[0], q.shape[1]
    nb = L // Q_BLOCK
    qb = q.reshape(bsz, nb, Q_BLOCK, 2, DIFF_HEADS, DIFF_HEAD_DIM).transpose(1, 0, 2, 3, 4, 5)
    key_chunk = jnp.arange(L) // CHUNK
    scale = DIFF_HEAD_DIM ** -0.5

    def one_block(args):
        qi, idx = args
        q_chunk = (idx * Q_BLOCK + jnp.arange(Q_BLOCK)) // CHUNK
        mask = key_chunk[None, :] <= q_chunk[:, None]
        s = jnp.einsum('bqchd,bkchd->bchqk', qi, k).astype(jnp.float32) * scale
        s = jnp.where(mask, s, -jnp.inf)
        p = jax.nn.softmax(s, axis=-1)
        a = p[:, 0] - lam * p[:, 1]
        return jnp.einsum('bhqk,bkhe->bqhe', a.astype(v.dtype), v)

    out = lax.map(one_block, (qb, jnp.arange(nb)))
    out = out.transpose(1, 0, 2, 3, 4).reshape(bsz, L, DIFF_HEADS, DIFF_V_DIM)
    out = rms_norm(out, sub_g) * (1.0 - lambda_init)
    return out.reshape(bsz, L, TOK_WIDTH)


def swiglu(h, wg, wu, wd):
    return (jax.nn.silu(h @ wg) * (h @ wu)) @ wd


def setup_inputs(seed: int = 0) -> dict:
    key = jax.random.key(seed)
    ks = iter(jax.random.split(key, 40))
    f32 = jnp.float32

    def nrm(shape, scale):
        return jax.random.normal(next(ks), shape, f32) * scale

    def gain(shape):
        return 1.0 + nrm(shape, 0.02)

    G, N, P = SSM_GROUPS, SSM_STATE, SSM_GROUP
    a_im_init = jnp.broadcast_to(jnp.pi * jnp.arange(N, dtype=f32), (N_A_LAYERS, G, N))
    return {
        "x": nrm((BATCH, SEQ, D_MODEL), 1.0),
        "mem": nrm((BATCH, N_MEM, D_MODEL), 1.0),
        "norm_mix": gain((DEPTH, D_MODEL)),
        "norm_ffn": gain((DEPTH, D_MODEL)),
        "norm_mem": gain((DEPTH, D_MODEL)),
        "w_in": nrm((DEPTH, D_MODEL, D_MODEL), D_MODEL ** -0.5),
        "w_out": nrm((DEPTH, D_MODEL, D_MODEL), D_MODEL ** -0.5),
        "mem_wk": nrm((DEPTH, D_MODEL, MEM_WIDTH), D_MODEL ** -0.5),
        "mem_wv": nrm((DEPTH, D_MODEL, MEM_WIDTH), D_MODEL ** -0.5),
        "mem_q_norm": gain((DEPTH, MEM_HEAD_DIM)),
        "mem_k_norm": gain((DEPTH, MEM_HEAD_DIM)),
        "ffn_w_gate": nrm((DEPTH, D_MODEL, D_FF), D_MODEL ** -0.5),
        "ffn_w_up": nrm((DEPTH, D_MODEL, D_FF), D_MODEL ** -0.5),
        "ffn_w_down": nrm((DEPTH, D_FF, D_MODEL), D_FF ** -0.5),
        "ssm_a_re": -0.5 + nrm((N_A_LAYERS, G, N), 0.01),
        "ssm_a_im": a_im_init + nrm((N_A_LAYERS, G, N), 0.01),
        "ssm_log_dt": jax.random.uniform(next(ks), (N_A_LAYERS, G), f32,
                                         minval=math.log(DT_MIN), maxval=math.log(DT_MAX)),
        "ssm_b_re": nrm((N_A_LAYERS, G, N, P), (2 * P) ** -0.5),
        "ssm_b_im": nrm((N_A_LAYERS, G, N, P), (2 * P) ** -0.5),
        "ssm_c_re": nrm((N_A_LAYERS, G, P, N), (2 * N) ** -0.5),
        "ssm_c_im": nrm((N_A_LAYERS, G, P, N), (2 * N) ** -0.5),
        "ssm_d": nrm((N_A_LAYERS, TOK_WIDTH), 0.5),
        "ssm_w_glu": nrm((N_A_LAYERS, TOK_WIDTH, TOK_WIDTH), TOK_WIDTH ** -0.5),
        "kv_norm": gain((D_MODEL,)),
        "diff_wk": nrm((D_MODEL, TOK_WIDTH), D_MODEL ** -0.5),
        "diff_wv": nrm((D_MODEL, TOK_WIDTH), D_MODEL ** -0.5),
        "diff_k_norm": gain((DIFF_HEAD_DIM,)),
        "diff_q_norm": gain((N_B_LAYERS, DIFF_HEAD_DIM)),
        "diff_lambda_q1": nrm((N_B_LAYERS, DIFF_HEAD_DIM), 0.1),
        "diff_lambda_k1": nrm((N_B_LAYERS, DIFF_HEAD_DIM), 0.1),
        "diff_lambda_q2": nrm((N_B_LAYERS, DIFF_HEAD_DIM), 0.1),
        "diff_lambda_k2": nrm((N_B_LAYERS, DIFF_HEAD_DIM), 0.1),
        "diff_sub_norm": gain((N_B_LAYERS, DIFF_V_DIM)),
    }


def reference(x, mem, norm_mix, norm_ffn, norm_mem, w_in, w_out, mem_wk, mem_wv,
              mem_q_norm, mem_k_norm, ffn_w_gate, ffn_w_up, ffn_w_down,
              ssm_a_re, ssm_a_im, ssm_log_dt, ssm_b_re, ssm_b_im, ssm_c_re, ssm_c_im,
              ssm_d, ssm_w_glu, kv_norm, diff_wk, diff_wv, diff_k_norm, diff_q_norm,
              diff_lambda_q1, diff_lambda_k1, diff_lambda_q2, diff_lambda_k2, diff_sub_norm):
    bsz, L, _ = x.shape
    k_shared = None
    v_shared = None
    for layer in range(DEPTH):
        h = rms_norm(x, norm_mix[layer])
        z = h @ w_in[layer]
        z_tok, z_mem = z[..., :TOK_WIDTH], z[..., TOK_WIDTH:]
        mem_n = rms_norm(mem, norm_mem[layer])
        o_mem = memory_attention(z_mem, mem_n, mem_wk[layer], mem_wv[layer],
                                 mem_q_norm[layer], mem_k_norm[layer])
        if layer < N_A_LAYERS:
            i = layer
            o_tok = s5_mixer(z_tok, ssm_a_re[i], ssm_a_im[i], ssm_log_dt[i], ssm_b_re[i],
                             ssm_b_im[i], ssm_c_re[i], ssm_c_im[i], ssm_d[i], ssm_w_glu[i])
        else:
            j = layer - N_A_LAYERS
            lambda_init = 0.8 - 0.6 * math.exp(-0.3 * layer)
            lam = (jnp.exp(jnp.sum(diff_lambda_q1[j].astype(jnp.float32) * diff_lambda_k1[j].astype(jnp.float32)))
                   - jnp.exp(jnp.sum(diff_lambda_q2[j].astype(jnp.float32) * diff_lambda_k2[j].astype(jnp.float32)))
                   + lambda_init)
            q = rms_norm(z_tok.reshape(bsz, L, 2, DIFF_HEADS, DIFF_HEAD_DIM), diff_q_norm[j])
            o_tok = diff_attention(q, k_shared, v_shared, lam, diff_sub_norm[j], lambda_init)
        x = x + jnp.concatenate([o_tok.astype(x.dtype), o_mem.astype(x.dtype)], axis=-1) @ w_out[layer]
        h = rms_norm(x, norm_ffn[layer])
        x = x + swiglu(h, ffn_w_gate[layer], ffn_w_up[layer], ffn_w_down[layer])
        if layer == N_A_LAYERS - 1:
            hk = rms_norm(x, kv_norm)
            k_shared = rms_norm((hk @ diff_wk).reshape(bsz, L, 2, DIFF_HEADS, DIFF_HEAD_DIM), diff_k_norm)
            v_shared = (hk @ diff_wv).reshape(bsz, L, DIFF_HEADS, DIFF_V_DIM)
    return x
```

```cpp
#include <hip/hip_runtime.h>
#include <hip/hip_cooperative_groups.h>
#include <cstdio>
#include <cstdint>
namespace cg = cooperative_groups;
#ifndef MK_MULTI
#define MK_MULTI 0
#endif
__device__ __forceinline__ int tidx() { int t = threadIdx.x; asm volatile("" : "+v"(t)); return t; }
namespace pg8 {
#define PG8_LAS __attribute__((address_space(3)))
typedef unsigned short bf16_t;
typedef short bf16x8 __attribute__((ext_vector_type(8)));
typedef float f32x4 __attribute__((ext_vector_type(4)));
typedef unsigned u32x4 __attribute__((ext_vector_type(4)));
constexpr int BM = 256, BK = 64, HALF = 128, HTB = HALF * BK * 2  , STAGE_BYTES = 8 * HTB, NXCD = 8, WGM = 8;

__host__ __device__ __forceinline__ int lds_byte(int r, int c) { const int st = (r >> 4) * 2 + (c >> 5), rr = r & 15, cc = c & 31, ob = rr * 64 + cc * 2; return st * 1024 + (ob ^ (((ob >> 9) & 1) << 5)); }
__host__ __device__ __forceinline__ void stage_rc(int b, int& R, int& C) { const int st = b / 1024, sb = b % 1024, swz = sb ^ (((sb >> 9) & 1) << 5); R = (st >> 1) * 16 + swz / 64; C = (st & 1) * 32 + (swz % 64) / 2; }
__host__ __device__ __forceinline__ int perm32(int rho) { const int n = rho >> 4, i = rho & 15; return 8 * (i >> 2) + 4 * n + (i & 3); }

struct Unit { int pm, pn; };
struct Gemm { const bf16_t* A; const bf16_t* Bt; int M, N, K; size_t a_gap; };

struct StaticOrder {
    int nM, nN, nwg, G, c;
    __host__ __device__ void init(int M, int N, int G_, int c_) { nM = M / BM; nN = N / BM; nwg = nM * nN; G = G_; c = c_; }
    __host__ __device__ bool next(int i, Unit& u) const {
        const long L = (long)i * G + c; if (L >= nwg) return false;
        int wgid = (int)L; { const int q = nwg / NXCD, r = nwg % NXCD, xcd = wgid % NXCD, off = wgid / NXCD; wgid = (xcd < r ? xcd * (q + 1) : r * (q + 1) + (xcd - r) * q) + off; }
        const int nig = WGM * nN, gid = wgid / nig, fm = gid * WGM, gsz = (nM - fm) < WGM ? (nM - fm) : WGM;
        u.pm = fm + ((wgid % nig) % gsz); u.pn = (wgid % nig) / gsz; return true;
    }
    __device__ __forceinline__ void a_ready(const Unit&) const {}
    __device__ __forceinline__ void done(const Unit&) const {}
};

__device__ __forceinline__ unsigned cvt_pk_bf16(float lo, float hi) { unsigned r; asm volatile("v_cvt_pk_bf16_f32 %0, %1, %2" : "=v"(r) : "v"(lo), "v"(hi)); return r; }
typedef float f32x2 __attribute__((ext_vector_type(2)));
template <class Epi, class Sched, bool ALIGN_EPI = false, bool SP2 = false>
__device__ __forceinline__ void gemm_phase(PG8_LAS unsigned char* lds, const Gemm g, const Sched& S, const Epi& E) {
    const int tid = tidx(), wid = __builtin_amdgcn_readfirstlane(tid >> 6), lane = tid & 63, wr = wid >> 2, wc = wid & 3, fr = lane & 15, fq = lane >> 4;
    const int K = g.K, nt = K / BK;
    unsigned voffA[2], voffB[2];
#pragma unroll
    for (int i = 0; i < 2; ++i) { int R, C; stage_rc(tid * 16 + i * 8192, R, C); const int Rb = Epi::PERM ? ((R & ~31) + perm32(R & 31)) : R;
        voffA[i] = (unsigned)(R * K + C) * 2u; voffB[i] = (unsigned)(Rb * K + C) * 2u; }
    const size_t kstep = (size_t)(BK * 2);
    const size_t hstep = (size_t)HALF * K * 2;
    const size_t tstep = 2 * hstep;
    const unsigned ldsw = (unsigned)wid * 1024u;
    const int aoff = lds_byte(wr * 64 + fr, fq * 8), boff = lds_byte(wc * 32 + fr, fq * 8);
#define PG8_SA(b, h) (((b) * 2 + (h)) * HTB)
#define PG8_SB(b, h) ((4 + (b) * 2 + (h)) * HTB)
#define PG8_STAGE(bufoff, gbase, voff) do { _Pragma("unroll") for (int _i = 0; _i < 2; ++_i) \
        __builtin_amdgcn_global_load_lds((const unsigned*)((const char*)(gbase) + (voff)[_i]), (PG8_LAS unsigned*)(lds + (bufoff) + ldsw + _i * 8192), 16, 0, 0); } while (0)
#define PG8_LDA(dst, b, h) do { _Pragma("unroll") for (int m = 0; m < 4; ++m) _Pragma("unroll") for (int k = 0; k < 2; ++k) dst[m][k] = *(const PG8_LAS bf16x8*)(lds + PG8_SA(b, h) + aoff + m * 2048 + k * 1024); } while (0)
#define PG8_LDB(dst, b, h) do { _Pragma("unroll") for (int n = 0; n < 2; ++n) _Pragma("unroll") for (int k = 0; k < 2; ++k) dst[n][k] = *(const PG8_LAS bf16x8*)(lds + PG8_SB(b, h) + boff + n * 2048 + k * 1024); } while (0)
#define PG8_MMA(ai, bj, At, Bt) do { __builtin_amdgcn_s_setprio(1); _Pragma("unroll") for (int m = 0; m < 4; ++m) _Pragma("unroll") for (int n = 0; n < 2; ++n) _Pragma("unroll") for (int k = 0; k < 2; ++k) \
        acc[ai][bj][m][n] = __builtin_amdgcn_mfma_f32_16x16x32_bf16(Bt[n][k], At[m][k], acc[ai][bj][m][n], 0, 0, 0); __builtin_amdgcn_s_setprio(0); } while (0)
#define PG8_WAIT_V(n) asm volatile("s_waitcnt vmcnt(" #n ")" ::: "memory")
#define PG8_WAIT_L(n) asm volatile("s_waitcnt lgkmcnt(" #n ")" ::: "memory")
#define PG8_BAR __builtin_amdgcn_s_barrier()
#define PG8_SCHED __builtin_amdgcn_sched_barrier(0)
    Unit cur, nxt; int ui = 0;
    if (!S.next(0, cur)) return;
    f32x4 acc[2][2][4][2];
#pragma unroll
    for (int a = 0; a < 2; ++a)
#pragma unroll
        for (int b = 0; b < 2; ++b)
#pragma unroll
            for (int m = 0; m < 4; ++m)
#pragma unroll
                for (int n = 0; n < 2; ++n) acc[a][b][m][n] = (f32x4){0.f, 0.f, 0.f, 0.f};
    bf16x8 At[4][2], B0[2][2], B1[2][2];
    const char* cA = (const char*)g.A + (size_t)cur.pm * tstep + (size_t)(cur.pm >> 3) * g.a_gap; const char* cB = (const char*)g.Bt + (size_t)cur.pn * tstep;
    S.a_ready(cur);
    if constexpr (SP2) {
        PG8_STAGE(PG8_SB(0, 0), cB, voffB); PG8_STAGE(PG8_SB(0, 1), cB + hstep, voffB); PG8_STAGE(PG8_SA(0, 0), cA, voffA); PG8_STAGE(PG8_SA(0, 1), cA + hstep, voffA);
        if (wr == 1) PG8_BAR;
        PG8_WAIT_V(2); PG8_BAR;
        PG8_STAGE(PG8_SB(1, 0), cB + kstep, voffB); PG8_STAGE(PG8_SA(1, 0), cA + kstep, voffA); PG8_STAGE(PG8_SB(1, 1), cB + hstep + kstep, voffB);
        PG8_WAIT_V(6); PG8_BAR;
    } else {
        PG8_STAGE(PG8_SB(0, 0), cB, voffB); PG8_STAGE(PG8_SA(0, 0), cA, voffA); PG8_STAGE(PG8_SB(0, 1), cB + hstep, voffB); PG8_STAGE(PG8_SA(0, 1), cA + hstep, voffA);
        if (wr == 1) PG8_BAR;
        PG8_WAIT_V(4); PG8_BAR;
        PG8_STAGE(PG8_SB(1, 0), cB + kstep, voffB); PG8_STAGE(PG8_SA(1, 0), cA + kstep, voffA); PG8_STAGE(PG8_SB(1, 1), cB + hstep + kstep, voffB);
        PG8_WAIT_V(6); PG8_BAR;
    }
    for (;;) {
        const bool has_next = S.next(ui + 1, nxt);
        const char* nA = has_next ? (const char*)g.A + (size_t)nxt.pm * tstep + (size_t)(nxt.pm >> 3) * g.a_gap : cA; const char* nB = has_next ? (const char*)g.Bt + (size_t)nxt.pn * tstep : cB;
        for (int t = 0; t < nt; t += 2) {
            const bool last = (t == nt - 2);
            const char* a1 = cA + (size_t)(t + 1) * kstep;
            const char* a2 = last ? nA : cA + (size_t)(t + 2) * kstep; const char* b2 = last ? nB : cB + (size_t)(t + 2) * kstep;
            const char* a3 = a2 + kstep; const char* b3 = b2 + kstep;
            if (last && has_next) S.a_ready(nxt);
            if constexpr (SP2) {
            PG8_LDB(B0, 0, 0); PG8_LDB(B1, 0, 1); PG8_SCHED; PG8_LDA(At, 0, 0); PG8_STAGE(PG8_SA(1, 1), a1 + hstep, voffA);
            PG8_WAIT_V(8); PG8_WAIT_L(0); PG8_BAR; PG8_MMA(0, 0, At, B0); PG8_MMA(0, 1, At, B1); PG8_BAR; PG8_SCHED;
            PG8_LDA(At, 0, 1); PG8_STAGE(PG8_SB(0, 0), b2, voffB); PG8_STAGE(PG8_SB(0, 1), b2 + hstep, voffB); PG8_STAGE(PG8_SA(0, 0), a2, voffA);
            PG8_WAIT_V(8); PG8_WAIT_L(0); PG8_BAR; PG8_MMA(1, 0, At, B0); PG8_MMA(1, 1, At, B1); PG8_BAR; PG8_SCHED;
            PG8_LDB(B0, 1, 0); PG8_LDB(B1, 1, 1); PG8_SCHED; PG8_LDA(At, 1, 0); PG8_STAGE(PG8_SA(0, 1), a2 + hstep, voffA);
            PG8_WAIT_V(8); PG8_WAIT_L(0); PG8_BAR; PG8_MMA(0, 0, At, B0); PG8_MMA(0, 1, At, B1); PG8_BAR; PG8_SCHED;
            PG8_LDA(At, 1, 1); PG8_STAGE(PG8_SB(1, 0), b3, voffB); PG8_STAGE(PG8_SB(1, 1), b3 + hstep, voffB); PG8_STAGE(PG8_SA(1, 0), a3, voffA);
            PG8_WAIT_V(8); PG8_WAIT_L(0); PG8_BAR; PG8_MMA(1, 0, At, B0); PG8_MMA(1, 1, At, B1); PG8_BAR; PG8_SCHED;
            } else {
            PG8_LDB(B0, 0, 0); PG8_SCHED; PG8_LDA(At, 0, 0); PG8_STAGE(PG8_SA(1, 1), a1 + hstep, voffA);
            PG8_WAIT_L(8); PG8_BAR; PG8_WAIT_L(0); PG8_MMA(0, 0, At, B0); PG8_BAR; PG8_SCHED;
            PG8_LDB(B1, 0, 1); PG8_STAGE(PG8_SB(0, 0), b2, voffB);
            PG8_BAR; PG8_WAIT_L(0); PG8_MMA(0, 1, At, B1); PG8_BAR;
            PG8_LDA(At, 0, 1); PG8_STAGE(PG8_SA(0, 0), a2, voffA);
            PG8_BAR; PG8_WAIT_L(0); PG8_MMA(1, 0, At, B0); PG8_BAR; PG8_SCHED;
            PG8_STAGE(PG8_SB(0, 1), b2 + hstep, voffB);
            PG8_WAIT_V(6); PG8_BAR; PG8_MMA(1, 1, At, B1); PG8_BAR;
            PG8_LDB(B0, 1, 0); PG8_SCHED; PG8_LDA(At, 1, 0); PG8_STAGE(PG8_SA(0, 1), a2 + hstep, voffA);
            PG8_WAIT_L(8); PG8_BAR; PG8_WAIT_L(0); PG8_MMA(0, 0, At, B0); PG8_BAR; PG8_SCHED;
            PG8_LDB(B1, 1, 1); PG8_STAGE(PG8_SB(1, 0), b3, voffB);
            PG8_BAR; PG8_WAIT_L(0); PG8_MMA(0, 1, At, B1); PG8_BAR;
            PG8_LDA(At, 1, 1); PG8_STAGE(PG8_SA(1, 0), a3, voffA);
            PG8_BAR; PG8_WAIT_L(0); PG8_MMA(1, 0, At, B0); PG8_BAR; PG8_SCHED;
            PG8_STAGE(PG8_SB(1, 1), b3 + hstep, voffB);
            PG8_WAIT_V(6); PG8_BAR; PG8_MMA(1, 1, At, B1); PG8_BAR;
            }
        }
        if constexpr (ALIGN_EPI) { if (wr == 0) PG8_BAR; }
        if constexpr (!Epi::AFTER_DRAIN) { E(acc, cur, wr, wc, fr, fq); S.done(cur); }
        if (!has_next) break;
#pragma unroll
        for (int a = 0; a < 2; ++a)
#pragma unroll
            for (int b = 0; b < 2; ++b)
#pragma unroll
                for (int m = 0; m < 4; ++m)
#pragma unroll
                    for (int n = 0; n < 2; ++n) acc[a][b][m][n] = (f32x4){0.f, 0.f, 0.f, 0.f};
        cur = nxt; cA = nA; cB = nB; ++ui;
        if constexpr (ALIGN_EPI) { if (wr == 1) PG8_BAR; }
    }
    PG8_WAIT_V(0);
    if constexpr (!ALIGN_EPI) { if (wr == 0) PG8_BAR; }
    PG8_BAR;
    if constexpr (Epi::AFTER_DRAIN) { E.fused(acc, cur, wr, wc, fr, fq, lds, wid, lane); S.done(cur); }
#undef PG8_SA
#undef PG8_SB
#undef PG8_STAGE
#undef PG8_LDA
#undef PG8_LDB
#undef PG8_MMA
#undef PG8_WAIT_V
#undef PG8_WAIT_L
#undef PG8_BAR
#undef PG8_SCHED
}
}

using pg8::bf16_t; using pg8::bf16x8; using pg8::f32x4; using pg8::u32x4;
typedef float f32x16 __attribute__((ext_vector_type(16)));
typedef unsigned u32x2 __attribute__((ext_vector_type(2)));
typedef float f32x2_t __attribute__((ext_vector_type(2)));
typedef __bf16 bf16x2_t __attribute__((ext_vector_type(2)));
#define LAS __attribute__((address_space(3)))
#define DI __device__ __forceinline__

constexpr int DM = 1024, NB = 8, SEQ = 2048, MT = NB * SEQ, NMEM = 256, MMEM = NB * NMEM, TOKW = 768, DFF = 2816;
constexpr float EPS = 1e-6f, LOG2E = 1.4426950408889634f, QSCALE = 0.125f * 1.4426950408889634f;
constexpr int NWAVES = 8, NTHREADS = 512;
#define REP_KIND -1
#define REP_LAYERS 0xF
constexpr int LDS_BYTES = 148480;

constexpr size_t KiB = 1024, MiB = 1024 * 1024;
constexpr size_t WS_SSQ = 226 * MiB, WS_SSQM = 235 * MiB;
constexpr size_t WS_BAR = 0, BAR_ZERO_BYTES = 32 * KiB;
constexpr size_t WS_ABAR = 1 * MiB, WS_BBT = 1 * MiB + 64 * KiB, WS_CT = 1 * MiB + 448 * KiB;
constexpr size_t WS_MEMK = 2 * MiB, WS_MEMVT = 6 * MiB, WS_XB = 10 * MiB;
constexpr size_t WS_Z = 42 * MiB, WS_CAT = 46 * MiB, WS_HSSM = 50 * MiB, WS_HID = 42 * MiB, Z_GAP = 7 * MiB, CAT_GAP = 7 * MiB, HS_GAP = 8 * MiB;
constexpr size_t WS_WMEMKV = 130 * MiB, WS_MEMB = 134 * MiB, WS_KD = 130 * MiB, WS_VT = 154 * MiB;
constexpr size_t WS_WKV = 184 * MiB, WS_END = 236 * MiB;
__host__ __device__ constexpr size_t w_in_off(int l)  { return l == 0 ? 138 * MiB : l == 1 ? 140 * MiB : l == 2 ? 182 * MiB : 187 * MiB; }
__host__ __device__ constexpr size_t w_out_off(int l) { return l == 0 ? 142 * MiB : l == 1 ? 144 * MiB : l == 2 ? 189 * MiB : 191 * MiB; }
__host__ __device__ constexpr size_t w_glu_off(int i) { return i == 0 ? 146 * MiB : 147 * MiB + 128 * KiB; }
__host__ __device__ constexpr size_t w_gu_off(int l)  { return l == 0 ? 148 * MiB + 256 * KiB : l == 1 ? 159 * MiB + 256 * KiB : l == 2 ? 193 * MiB : 204 * MiB; }
__host__ __device__ constexpr size_t w_d_off(int l)   { return l == 0 ? 170 * MiB + 256 * KiB : l == 1 ? 175 * MiB + 768 * KiB : l == 2 ? 215 * MiB : 220 * MiB + 512 * KiB; }

enum { I_X = 0, I_MEM, I_NMIX, I_NFFN, I_NMEM, I_WIN, I_WOUT, I_MWK, I_MWV, I_MQN, I_MKN, I_FG, I_FU, I_FD,
       I_ARE, I_AIM, I_LDT, I_BRE, I_BIM, I_CRE, I_CIM, I_SD, I_WGLU, I_KVN, I_DWK, I_DWV, I_DKN, I_DQN, I_LQ1, I_LK1, I_LQ2, I_LK2, I_SUBN, N_IN };

struct Args { const float* in[N_IN]; float* out; unsigned char* ws; double dc0, dc1, dc2; int ph_lo, ph_hi, ione, pad; };
typedef const __attribute__((address_space(4))) Args* ArgsP;

DI unsigned cvtpk(float lo, float hi) { f32x2_t v = {lo, hi}; bf16x2_t b = __builtin_convertvector(v, bf16x2_t); return __builtin_bit_cast(unsigned, b); }
DI float bf2f(unsigned short h) { return __uint_as_float(((unsigned)h) << 16); }
DI float bflo(unsigned w) { return __uint_as_float(w << 16); }
DI float bfhi(unsigned w) { return __uint_as_float(w & 0xffff0000u); }
DI float wave_sum(float v) {
#pragma unroll
    for (int o = 1; o < 64; o <<= 1) v += __shfl_xor(v, o);
    return v;
}
DI float wave_max(float v) {
#pragma unroll
    for (int o = 1; o < 64; o <<= 1) v = fmaxf(v, __shfl_xor(v, o));
    return v;
}
DI float fast_sigmoid(float x) { return __builtin_amdgcn_rcpf(1.0f + __builtin_amdgcn_exp2f(-x * LOG2E)); }
DI float gelu_tanh(float y) { const float t = 1.5957691216057308f * (y + 0.044715f * y * y * y); return y * fast_sigmoid(t); }
DI float row_rstd(const float* part, int fq) {
    const f32x4 p = *(const f32x4*)(part + 4 * fq);
    float s = (p[0] + p[1]) + (p[2] + p[3]);
    s += __shfl_xor(s, 16); s += __shfl_xor(s, 32);
    return rsqrtf(s * (1.0f / DM) + EPS);
}
#define MFMA32(a, b, c) __builtin_amdgcn_mfma_f32_32x32x16_bf16((a), (b), (c), 0, 0, 0)
#define MFMA16(a, b, c) __builtin_amdgcn_mfma_f32_16x16x32_bf16((a), (b), (c), 0, 0, 0)

struct Epi {
    static constexpr bool PERM = true, AFTER_DRAIN = false;
    ArgsP a; LAS unsigned char* xl; int mode, layer, sub, pad;
    DI void operator()(const f32x4 (&acc)[2][2][4][2], const pg8::Unit& u, int wr, int wc, int fr, int fq) const {
        const int row0 = u.pm * 256 + wr * 64 + fr;
        const int cl = wc * 64 + 8 * fq;
        unsigned char* ws = a->ws;
        const int isB = layer >= 2;
        const float* ssq = (const float*)(ws + (mode == 1 ? WS_SSQM : WS_SSQ)) + (mode == 1 ? (size_t)0 : (size_t)(2 * layer + (mode == 4 ? 1 : 0)) * MT * 16);
        bf16_t* o0 = (bf16_t*)(ws + (mode == 0 ? WS_Z + (size_t)(u.pm >> 3) * Z_GAP : mode == 1 ? WS_MEMK : mode == 2 ? WS_CAT + (size_t)(u.pm >> 3) * CAT_GAP : mode == 3 ? WS_XB : WS_HID));
        float rs8[2][4];
        if (mode == 0 || mode == 1 || mode == 4) {
            f32x4 pp[2][4];
#pragma unroll
            for (int ai = 0; ai < 2; ++ai)
#pragma unroll
                for (int m = 0; m < 4; ++m) pp[ai][m] = *(const f32x4*)((const char*)ssq + ((unsigned)(row0 * 64 + fq * 16) + (unsigned)((ai * 128 + m * 16) * 64)));
#pragma unroll
            for (int ai = 0; ai < 2; ++ai)
#pragma unroll
                for (int m = 0; m < 4; ++m) { float s = (pp[ai][m][0] + pp[ai][m][1]) + (pp[ai][m][2] + pp[ai][m][3]); s += __shfl_xor(s, 16); s += __shfl_xor(s, 32); rs8[ai][m] = rsqrtf(s * (1.0f / DM) + EPS); }
        }
        if (mode == 0 || mode == 1) {
            int kind;
            const float* gain = nullptr; float gscale = 1.f; bf16_t* dst = o0; int pitch = DM, colbase = 0;
            bf16_t* tdst = nullptr; int tpitch = 0, tcol0 = 0;
            const int pn = u.pn;
            if (mode == 0) {
                if (pn < 3) { kind = isB ? 1 : 0; gain = a->in[I_DQN] + (isB ? (layer - 2) * 64 : 0); gscale = QSCALE; colbase = pn * 256; }
                else if (pn == 3) { kind = 1; gain = a->in[I_MQN] + layer * 64; gscale = QSCALE; colbase = 768; }
                else if (pn < 7) { kind = 1; gain = a->in[I_DKN]; gscale = 1.f; dst = (bf16_t*)(ws + WS_KD); pitch = TOKW; colbase = (pn - 4) * 256; }
                else { kind = 2; const int b = (u.pm * 256) / SEQ; const int h = (pn - 7) * 2 + (wc >> 1);
                       tdst = (bf16_t*)(ws + WS_VT) + ((size_t)(b * 6 + h) * 128 + (wc & 1) * 64) * SEQ; tpitch = SEQ; tcol0 = (u.pm * 256) % SEQ + wr * 64 + fr; }
            } else {
                const int lm = pn >> 1;
                if ((pn & 1) == 0) { kind = 1; gain = a->in[I_MKN] + lm * 64; gscale = 1.f; dst = o0 + (size_t)lm * MMEM * 256; pitch = 256; colbase = 0; }
                else { kind = 2; const int b = u.pm; tdst = (bf16_t*)(ws + WS_MEMVT) + (size_t)lm * MMEM * 256 + ((size_t)(b * 4 + wc) * 64) * NMEM; tpitch = NMEM; tcol0 = wr * 64 + fr; }
            }
            if (kind != 2) {
                f32x4 gn[2][2];
#pragma unroll
                for (int bj = 0; bj < 2; ++bj)
#pragma unroll
                    for (int n = 0; n < 2; ++n) gn[bj][n] = (kind == 1) ? *(const f32x4*)(gain + bj * 32 + 8 * fq + 4 * n) * gscale : (f32x4){1.f, 1.f, 1.f, 1.f};
#pragma unroll
                for (int ai = 0; ai < 2; ++ai)
#pragma unroll
                    for (int m = 0; m < 4; ++m) {
                        const int row = row0 + ai * 128 + m * 16;
                        const float rs = rs8[ai][m];
                        f32x4 v[2][2];
                        float ss = 0.f;
#pragma unroll
                        for (int bj = 0; bj < 2; ++bj)
#pragma unroll
                            for (int n = 0; n < 2; ++n) { v[bj][n] = acc[ai][bj][m][n] * rs; const f32x4 q = v[bj][n] * v[bj][n]; ss += (q[0] + q[1]) + (q[2] + q[3]); }
                        if (kind == 1) {
                            ss += __shfl_xor(ss, 16); ss += __shfl_xor(ss, 32);
                            const float hn = rsqrtf(ss * (1.0f / 64.0f) + EPS);
#pragma unroll
                            for (int bj = 0; bj < 2; ++bj)
#pragma unroll
                                for (int n = 0; n < 2; ++n) v[bj][n] = v[bj][n] * gn[bj][n] * hn;
                        }
                        const unsigned ob = (unsigned)(row * pitch + colbase + cl) * 2u;
#pragma unroll
                        for (int bj = 0; bj < 2; ++bj) {
                            u32x4 w; w.x = cvtpk(v[bj][0][0], v[bj][0][1]); w.y = cvtpk(v[bj][0][2], v[bj][0][3]); w.z = cvtpk(v[bj][1][0], v[bj][1][1]); w.w = cvtpk(v[bj][1][2], v[bj][1][3]);
                            *(u32x4*)((char*)dst + ob + bj * 64) = w;
                        }
                        if (m & 1) asm volatile("" ::: "memory");
                    }
            } else {
                LAS unsigned char* tb = xl + (wr * 4 + wc) * 2048;
                const int tcolb = tcol0 - fr;
                const int lane_ = fq * 16 + fr;
#pragma unroll
                for (int ai = 0; ai < 2; ++ai)
#pragma unroll
                    for (int m = 0; m < 4; ++m) {
                        const float rs = rs8[ai][m];
#pragma unroll
                        for (int bj = 0; bj < 2; ++bj)
#pragma unroll
                            for (int n = 0; n < 2; ++n)
#pragma unroll
                                for (int j = 0; j < 4; ++j)
                                    *(LAS bf16_t*)(tb + (bj * 32 + 8 * fq + 4 * n + j) * 32 + fr * 2) = (bf16_t)(cvtpk(acc[ai][bj][m][n][j] * rs, 0.f) & 0xffffu);
                        asm volatile("s_waitcnt lgkmcnt(0)" ::: "memory");
#pragma unroll
                        for (int q = 0; q < 2; ++q) {
                            const int chunk = lane_ + 64 * q, e = chunk >> 1, half = chunk & 1;
                            const u32x4 tv = *(const LAS u32x4*)(tb + e * 32 + half * 16);
                            *(u32x4*)((char*)tdst + (unsigned)(e * tpitch + tcolb + ai * 128 + m * 16 + half * 8) * 2u) = tv;
                        }
                        asm volatile("s_waitcnt lgkmcnt(0)" ::: "memory");
                    }
            }
        } else if (mode == 2) {
            const bf16_t* hin = (const bf16_t*)(ws + WS_HSSM + (size_t)(u.pm >> 3) * HS_GAP);
#pragma unroll
            for (int ai = 0; ai < 2; ++ai) {
                u32x4 hw[4][2];
#pragma unroll
                for (int m = 0; m < 4; ++m)
#pragma unroll
                    for (int bj = 0; bj < 2; ++bj) hw[m][bj] = *(const u32x4*)((const char*)hin + ((unsigned)(row0 * TOKW + u.pn * 256 + cl) * 2u + (unsigned)(((ai * 128 + m * 16) * TOKW + bj * 32) * 2)));
#pragma unroll
                for (int m = 0; m < 4; ++m) {
                    const int row = row0 + ai * 128 + m * 16;
#pragma unroll
                    for (int bj = 0; bj < 2; ++bj) {
                        const int col = u.pn * 256 + cl + bj * 32;
                        const u32x4 h4 = hw[m][bj];
                        const f32x4 a0 = acc[ai][bj][m][0], a1 = acc[ai][bj][m][1];
                        u32x4 w;
                        w.x = cvtpk(bflo(h4.x) * fast_sigmoid(a0[0]), bfhi(h4.x) * fast_sigmoid(a0[1]));
                        w.y = cvtpk(bflo(h4.y) * fast_sigmoid(a0[2]), bfhi(h4.y) * fast_sigmoid(a0[3]));
                        w.z = cvtpk(bflo(h4.z) * fast_sigmoid(a1[0]), bfhi(h4.z) * fast_sigmoid(a1[1]));
                        w.w = cvtpk(bflo(h4.w) * fast_sigmoid(a1[2]), bfhi(h4.w) * fast_sigmoid(a1[3]));
                        *(u32x4*)((char*)o0 + (unsigned)(row * DM + col) * 2u) = w;
                    }
                }
                asm volatile("" ::: "memory");
            }
        } else if (mode == 3) {
            const float* xin = (sub == 0 && layer == 0) ? a->in[I_X] : (const float*)a->out; float* xout = a->out;
            float* ssq_out = (float*)(ws + WS_SSQ) + (size_t)(2 * layer + 1 + sub) * MT * 16;
            const unsigned xb0 = (unsigned)(row0 * DM + u.pn * 256 + cl) * 4u;
#pragma unroll
            for (int h2 = 0; h2 < 4; ++h2) {
                const int ai = h2 >> 1, mb = (h2 & 1) * 2;
                f32x4 xr[2][2][2];
#pragma unroll
                for (int mm = 0; mm < 2; ++mm)
#pragma unroll
                    for (int bj = 0; bj < 2; ++bj) { const unsigned off = xb0 + (unsigned)(((ai * 128 + (mb + mm) * 16) * DM + bj * 32) * 4);
                        if (sub == 0 && layer == 0) { xr[mm][bj][0] = *(const f32x4*)((const char*)xin + off); xr[mm][bj][1] = *(const f32x4*)((const char*)xin + off + 16); }
                        else { const u32x4 hb = *(const u32x4*)((const char*)o0 + (off >> 1));
                               xr[mm][bj][0] = (f32x4){bflo(hb.x), bfhi(hb.x), bflo(hb.y), bfhi(hb.y)}; xr[mm][bj][1] = (f32x4){bflo(hb.z), bfhi(hb.z), bflo(hb.w), bfhi(hb.w)}; } }
#pragma unroll
                for (int mm = 0; mm < 2; ++mm) {
                    const int m = mb + mm;
                    float ss = 0.f;
#pragma unroll
                    for (int bj = 0; bj < 2; ++bj) {
                        const unsigned off = xb0 + (unsigned)(((ai * 128 + m * 16) * DM + bj * 32) * 4);
                        const f32x4 x0 = xr[mm][bj][0] + acc[ai][bj][m][0];
                        const f32x4 x1 = xr[mm][bj][1] + acc[ai][bj][m][1];
                        if (sub == 1 && layer == 3) { *(f32x4*)((char*)xout + off) = x0; *(f32x4*)((char*)xout + off + 16) = x1; }
                        const f32x4 q0 = x0 * x0, q1 = x1 * x1;
                        ss += (q0[0] + q0[1]) + (q0[2] + q0[3]) + (q1[0] + q1[1]) + (q1[2] + q1[3]);
                        u32x4 w; w.x = cvtpk(x0[0], x0[1]); w.y = cvtpk(x0[2], x0[3]); w.z = cvtpk(x1[0], x1[1]); w.w = cvtpk(x1[2], x1[3]);
                        if (!(sub == 1 && layer == 3)) *(u32x4*)((char*)o0 + (off >> 1)) = w;
                    }
                    ss += __shfl_xor(ss, 16); ss += __shfl_xor(ss, 32);
                    if (fq == 0 && !(sub == 1 && layer == 3)) ssq_out[(size_t)(row0 + ai * 128 + m * 16) * 16 + u.pn * 4 + wc] = ss;
                }
                asm volatile("" ::: "memory");
            }
        } else {
#pragma unroll
            for (int ai = 0; ai < 2; ++ai)
#pragma unroll
                for (int m = 0; m < 4; ++m) {
                    const int row = row0 + ai * 128 + m * 16;
                    const float rs = rs8[ai][m];
                    const float c1 = -rs * LOG2E, c2 = rs * rs;
                    float o[8];
#pragma unroll
                    for (int n = 0; n < 2; ++n)
#pragma unroll
                        for (int j = 0; j < 4; ++j) { const float ag = acc[ai][0][m][n][j], au = acc[ai][1][m][n][j];
                            const float r = __builtin_amdgcn_rcpf(1.0f + __builtin_amdgcn_exp2f(ag * c1)); o[n * 4 + j] = (ag * au) * (c2 * r); }
                    u32x4 w; w.x = cvtpk(o[0], o[1]); w.y = cvtpk(o[2], o[3]); w.z = cvtpk(o[4], o[5]); w.w = cvtpk(o[6], o[7]);
                    *(u32x4*)((char*)o0 + (unsigned)(row * DFF + u.pn * 128 + wc * 32 + 8 * fq) * 2u) = w;
                    if (m & 1) asm volatile("" ::: "memory");
                }
        }
    }
};

DI void tr_item(const float* W, int ldw, int col0, const float* gain, bf16_t* dst, int K, int k0, LAS float* scr, int lane) {
    f32x4 v[8];
    const int c4 = (lane & 7) * 4, kr = lane >> 3;
#pragma unroll
    for (int i = 0; i < 8; ++i) v[i] = *(const f32x4*)(W + (size_t)(k0 + kr + 8 * i) * ldw + col0 + c4);
    if (gain) {
#pragma unroll
        for (int i = 0; i < 8; ++i) v[i] = v[i] * gain[k0 + kr + 8 * i];
    }
#pragma unroll
    for (int i = 0; i < 8; ++i) { LAS float* s = scr + (kr + 8 * i) * 33 + c4; s[0] = v[i][0]; s[1] = v[i][1]; s[2] = v[i][2]; s[3] = v[i][3]; }
    asm volatile("s_waitcnt lgkmcnt(0)" ::: "memory");
    const int c = lane & 7;
#pragma unroll
    for (int j = 0; j < 4; ++j) { const int n = (lane >> 3) + 8 * j; const LAS float* s = scr + (8 * c) * 33 + n;
        u32x4 o; o.x = cvtpk(s[0 * 33], s[1 * 33]); o.y = cvtpk(s[2 * 33], s[3 * 33]); o.z = cvtpk(s[4 * 33], s[5 * 33]); o.w = cvtpk(s[6 * 33], s[7 * 33]);
        *(u32x4*)(dst + (size_t)n * K + k0 + 8 * c) = o; }
    asm volatile("s_waitcnt lgkmcnt(0)" ::: "memory");
}
DI int headmap_col0(int G) { const int pn = G >> 3, blk = G & 7, bj = blk >> 2, wc = blk & 3; return pn * 256 + wc * 64 + bj * 32; }

DI void sincos_d(double x, double& s, double& c, double inv2pi, double twopi_hi, double twopi_lo, int one) {
    const double k = rint(x * inv2pi);
    double r = fma(-k, twopi_hi, x); r = fma(-k, twopi_lo, r);
    const double r2 = r * r; double ts = (double)one, tc = (double)one, ssum = (double)one, csum = (double)one;
#pragma unroll
    for (int j = 1; j <= 15; ++j) { tc = -tc * r2 / (double)((2 * j - 1) * (2 * j) * one); csum += tc; ts = -ts * r2 / (double)((2 * j) * (2 * j + 1) * one); ssum += ts; }
    s = r * ssum; c = csum;
}
DI double exp_small_d(double x, int one) {
    double t = (double)one, sum = (double)one;
#pragma unroll
    for (int j = 1; j <= 18; ++j) { t = t * x / (double)(j * one); sum += t; }
    return sum;
}

constexpr int PER_LAYER = 512 + 512 + 2816 + 1408 + 256, MEMKV_AT = 5248, EXTRA_AT = 4 * PER_LAYER;
DI void conv_item(ArgsP a, unsigned char* ws, int it, LAS float* scr, int lane) {
    {
        if (it < 4 * PER_LAYER) {
            const int l = it / PER_LAYER; int r = it % PER_LAYER;
            if (r < 512) { const int kb = r >> 5, G = r & 31;
                tr_item(a->in[I_WIN] + (size_t)l * DM * DM, DM, headmap_col0(G), a->in[I_NMIX] + l * DM, (bf16_t*)(ws + w_in_off(l)) + (size_t)G * 32 * DM, DM, kb * 64, scr, lane); return; }
            r -= 512;
            if (r < 512) { const int kb = r >> 5, G = r & 31;
                tr_item(a->in[I_WOUT] + (size_t)l * DM * DM, DM, headmap_col0(G), nullptr, (bf16_t*)(ws + w_out_off(l)) + (size_t)G * 32 * DM, DM, kb * 64, scr, lane); return; }
            r -= 512;
            if (r < 2816) { const int kb = r / 176, G = r % 176; const int pn = G >> 3, blk = G & 7, bj = blk >> 2, wc = blk & 3;
                tr_item(a->in[bj ? I_FU : I_FG] + (size_t)l * DM * DFF, DFF, pn * 128 + wc * 32, a->in[I_NFFN] + l * DM, (bf16_t*)(ws + w_gu_off(l)) + (size_t)G * 32 * DM, DM, kb * 64, scr, lane); return; }
            r -= 2816;
            if (r < 1408) { const int kb = r >> 5, G = r & 31;
                tr_item(a->in[I_FD] + (size_t)l * DFF * DM, DM, headmap_col0(G), nullptr, (bf16_t*)(ws + w_d_off(l)) + (size_t)G * 32 * DFF, DFF, kb * 64, scr, lane); return; }
            r -= 1408;
            { const int kb = r >> 4, G = r & 15; const int kv = G >> 3;
              tr_item(a->in[kv ? I_MWV : I_MWK] + (size_t)l * DM * 256, 256, headmap_col0(G & 7), a->in[I_NMEM] + l * DM, (bf16_t*)(ws + WS_WMEMKV) + ((size_t)l * 512 + G * 32) * DM, DM, kb * 64, scr, lane); return; }
        }
        int r = it - 4 * PER_LAYER;
        if (r < 576) { const int i = r / 288; r %= 288; const int kb = r / 24, G = r % 24;
            tr_item(a->in[I_WGLU] + (size_t)i * TOKW * TOKW, TOKW, headmap_col0(G), nullptr, (bf16_t*)(ws + w_glu_off(i)) + (size_t)G * 32 * TOKW, TOKW, kb * 64, scr, lane); return; }
        r -= 576;
        { const int kb = r / 48, G = r % 48; const int kv = G / 24, Gl = G % 24;
          tr_item(a->in[kv ? I_DWV : I_DWK], TOKW, headmap_col0(Gl), a->in[I_KVN], (bf16_t*)(ws + WS_WKV) + (size_t)G * 32 * DM, DM, kb * 64, scr, lane); }
    }
}
DI int n_layer_items(int layer) { return MEMKV_AT + (layer < 2 ? 288 : layer == 2 ? 768 : 0); }
DI void conv_layer(ArgsP a, LAS unsigned char* lds, int layer, int k_lo, int k_hi, int gw, int NGW) {
    int tid = tidx();
    const int lane = tid & 63, wave = __builtin_amdgcn_readfirstlane(tid >> 6);
    LAS float* scr = (LAS float*)(lds + wave * 8448);
    unsigned char* ws = a->ws;
    const int n = n_layer_items(layer) < k_hi ? n_layer_items(layer) : k_hi;
    for (int k = k_lo + gw; k < n; k += NGW) {
        const int it = k < MEMKV_AT ? layer * PER_LAYER + k : (layer < 2 ? EXTRA_AT + layer * 288 + (k - MEMKV_AT) : EXTRA_AT + 576 + (k - MEMKV_AT));
        conv_item(a, ws, it, scr, lane);
    }
}
DI void prologue(ArgsP a, LAS unsigned char* lds) {
    int tid = tidx(); asm volatile("" : "+v"(tid));
    const int lane = tid & 63, wave = __builtin_amdgcn_readfirstlane(tid >> 6);
    const int gw = blockIdx.x * NWAVES + wave, NGW = gridDim.x * NWAVES;
    unsigned char* ws = a->ws;
    LAS float* scr = (LAS float*)(lds + wave * 8448);
    conv_layer(a, lds, 0, 0, 512, gw, NGW);
    for (int k = gw; k < 4 * 256; k += NGW) conv_item(a, ws, (k >> 8) * PER_LAYER + MEMKV_AT + (k & 255), scr, lane);
    for (int m = gw; m < MT + MMEM; m += NGW) {
        const bool ismem = m >= MT; const int row = ismem ? m - MT : m;
        const float* src = (ismem ? a->in[I_MEM] : a->in[I_X]) + (size_t)row * DM;
        bf16_t* dstb = (bf16_t*)(ws + (ismem ? WS_MEMB : WS_XB)) + (size_t)row * DM;
        float ss = 0.f;
#pragma unroll
        for (int j = 0; j < 4; ++j) { const f32x4 v = *(const f32x4*)(src + 4 * lane + 256 * j); ss += (v[0] * v[0] + v[1] * v[1]) + (v[2] * v[2] + v[3] * v[3]);
            u32x2 w; w.x = cvtpk(v[0], v[1]); w.y = cvtpk(v[2], v[3]); *(u32x2*)(dstb + 4 * lane + 256 * j) = w; }
        ss = wave_sum(ss);
        if (lane < 16) ((float*)(ws + (ismem ? WS_SSQM : WS_SSQ)))[(size_t)row * 16 + lane] = lane == 0 ? ss : 0.f;
    }
    for (int idx = blockIdx.x * NTHREADS + tid; idx < 2 * 48 * 64; idx += gridDim.x * NTHREADS) {
        const int n = idx & 63, gi = idx >> 6;
        const double are = (double)a->in[I_ARE][idx], aim = (double)a->in[I_AIM][idx];
        const int one = a->ione;
        double dt; { double xs = (double)a->in[I_LDT][gi]; xs = xs * 0.5 * 0.5 * 0.5 * 0.5 * 0.5; dt = exp_small_d(xs, one); dt *= dt; dt *= dt; dt *= dt; dt *= dt; dt *= dt; }
        const double mag = exp_small_d(dt * are, one);
        double sn, cs; sincos_d(dt * aim, sn, cs, a->dc0, a->dc1, a->dc2, one);
        const double abr = mag * cs, abi = mag * sn;
        const double den = are * are + aim * aim, nr = abr - (double)one;
        const double cre = (nr * are + abi * aim) / den, cim = (abi * are - nr * aim) / den;
        float* ab = (float*)(ws + WS_ABAR) + (size_t)idx * 2; ab[0] = (float)abr; ab[1] = (float)abi;
        bf16_t* bbt = (bf16_t*)(ws + WS_BBT); bf16_t* ct = (bf16_t*)(ws + WS_CT);
#pragma unroll 4
        for (int p = 0; p < 16; ++p) {
            const double bre = (double)a->in[I_BRE][(size_t)idx * 16 + p], bim = (double)a->in[I_BIM][(size_t)idx * 16 + p];
            const float vre = (float)(cre * bre - cim * bim), vim = (float)(cre * bim + cim * bre);
            bbt[(((size_t)gi * 2 + 0) * 64 + n) * 16 + p] = (bf16_t)(cvtpk(vre, 0.f) & 0xffffu);
            bbt[(((size_t)gi * 2 + 1) * 64 + n) * 16 + p] = (bf16_t)(cvtpk(vim, 0.f) & 0xffffu);
            const float c_re = a->in[I_CRE][((size_t)gi * 16 + p) * 64 + n], c_im = a->in[I_CIM][((size_t)gi * 16 + p) * 64 + n];
            *(unsigned*)(ct + ((size_t)gi * 16 + p) * 128 + 2 * n) = cvtpk(c_re, -c_im);
        }
    }
}

DI void ssm_scan32(f32x16 (&d)[2][2], float are, float aim, float& sre, float& sim) {
#pragma unroll
    for (int a4 = 0; a4 < 4; ++a4)
#pragma unroll
        for (int cc = 0; cc < 2; ++cc)
#pragma unroll
            for (int bb = 0; bb < 4; ++bb) {
                const float bre = d[0][cc][4 * a4 + bb], bim = d[1][cc][4 * a4 + bb];
                const float nre = fmaf(are, sre, fmaf(-aim, sim, bre)), nim = fmaf(are, sim, fmaf(aim, sre, bim));
                sre = nre; sim = nim;
            }
}
DI void ssm_bu(f32x16 (&d)[2][2], const bf16x8 uf, const bf16x8 (&bq)[2][2]) {
    f32x16 zero;
#pragma unroll
    for (int i = 0; i < 16; ++i) zero[i] = 0.f;
#pragma unroll
    for (int c = 0; c < 2; ++c)
#pragma unroll
        for (int nb = 0; nb < 2; ++nb) d[c][nb] = MFMA32(uf, bq[c][nb], zero);
#pragma unroll
    for (int c = 0; c < 2; ++c)
#pragma unroll
        for (int i = 0; i < 16; ++i) {
            auto rr = __builtin_amdgcn_permlane32_swap(__float_as_uint(d[c][0][i]), __float_as_uint(d[c][1][i]), false, false);
            d[c][0][i] = __uint_as_float(rr[0]); d[c][1][i] = __uint_as_float(rr[1]);
        }
}
DI void ssm_unit(LAS unsigned char* lds, int li, int b, int g, const bf16_t* Z, bf16_t* HS, const float* abar_t, const bf16_t* bbt, const bf16_t* ct, const float* dskip) {
    int tid = tidx(); asm volatile("" : "+v"(tid));
    const int lane = tid & 63, wid = __builtin_amdgcn_readfirstlane(tid >> 6), r = lane & 31, hl = lane >> 5, p16 = lane & 15, quad = lane >> 4;
    const int gi = li * 48 + g;
    const float are = abar_t[((size_t)gi * 64 + lane) * 2], aim = abar_t[((size_t)gi * 64 + lane) * 2 + 1];
    bf16x8 bq[2][2];
#pragma unroll
    for (int c = 0; c < 2; ++c)
#pragma unroll
        for (int nb = 0; nb < 2; ++nb) bq[c][nb] = *(const bf16x8*)(bbt + (((size_t)gi * 2 + c) * 64 + nb * 32 + r) * 16 + 8 * hl);
    const size_t tok0 = (size_t)b * SEQ + 256 * wid;
    float sre = 0.f, sim = 0.f;
    LAS unsigned char* ub = lds + 8 * 8704 + 4096 + wid * 8192;
    {
        bf16x8 ufa[8];
#pragma unroll
        for (int blk = 0; blk < 8; ++blk) ufa[blk] = *(const bf16x8*)(Z + (tok0 + 32 * blk + r) * DM + 16 * g + 8 * hl);
#pragma unroll
        for (int blk = 0; blk < 8; ++blk) *(LAS bf16x8*)(ub + (32 * blk + r) * 32 + hl * 16) = ufa[blk];
    }
    asm volatile("s_waitcnt lgkmcnt(0)" ::: "memory");
    for (int blk = 0; blk < 8; ++blk) {
        const bf16x8 uf = *(const LAS bf16x8*)(ub + (32 * blk + r) * 32 + hl * 16);
        f32x16 d[2][2]; ssm_bu(d, uf, bq);
        ssm_scan32(d, are, aim, sre, sim);
    }
    LAS float* ex = (LAS float*)(lds + 8 * 8704);
    ex[(wid * 64 + lane) * 2] = sre; ex[(wid * 64 + lane) * 2 + 1] = sim;
    __syncthreads();
    float pre = are, pim = aim;
#pragma unroll
    for (int i = 0; i < 8; ++i) { const float nr = pre * pre - pim * pim, ni = 2.f * pre * pim; pre = nr; pim = ni; }
    sre = 0.f; sim = 0.f;
    for (int i = 0; i < wid; ++i) { const float ere = ex[(i * 64 + lane) * 2], eim = ex[(i * 64 + lane) * 2 + 1];
        const float nre = fmaf(pre, sre, fmaf(-pim, sim, ere)), nim = fmaf(pre, sim, fmaf(pim, sre, eim)); sre = nre; sim = nim; }
    bf16x8 cf[4];
#pragma unroll
    for (int ks = 0; ks < 4; ++ks) cf[ks] = *(const bf16x8*)(ct + ((size_t)gi * 16 + p16) * 128 + 32 * ks + 8 * quad);
    const float dsk = dskip[16 * g + p16];
    LAS unsigned char* sb = lds + wid * 8704;
    for (int blk = 0; blk < 8; ++blk) {
        const bf16x8 uf = *(const LAS bf16x8*)(ub + (32 * blk + r) * 32 + hl * 16);
        f32x16 d[2][2]; ssm_bu(d, uf, bq);
#pragma unroll
        for (int a4 = 0; a4 < 4; ++a4)
#pragma unroll
            for (int cc = 0; cc < 2; ++cc)
#pragma unroll
                for (int bb = 0; bb < 4; ++bb) {
                    const float bre = d[0][cc][4 * a4 + bb], bim = d[1][cc][4 * a4 + bb];
                    const float nre = fmaf(are, sre, fmaf(-aim, sim, bre)), nim = fmaf(are, sim, fmaf(aim, sre, bim));
                    sre = nre; sim = nim;
                    *(LAS unsigned*)(sb + (8 * a4 + 4 * cc + bb) * 272 + lane * 4) = cvtpk(sre, sim);
                }
        asm volatile("s_waitcnt lgkmcnt(0)" ::: "memory");
#pragma unroll
        for (int mb = 0; mb < 2; ++mb) {
            f32x4 y = {0.f, 0.f, 0.f, 0.f};
#pragma unroll
            for (int ks = 0; ks < 4; ++ks) { const bf16x8 af = *(const LAS bf16x8*)(sb + (16 * mb + p16) * 272 + 64 * ks + 16 * quad); y = MFMA16(af, cf[ks], y); }
#pragma unroll
            for (int j = 0; j < 4; ++j) {
                LAS bf16_t* up1 = (LAS bf16_t*)(ub + (32 * blk + 16 * mb + 4 * quad + j) * 32 + p16 * 2);
                const float uu = bf2f(*up1);
                const float hh = gelu_tanh(y[j] + dsk * uu);
                *up1 = (bf16_t)(cvtpk(hh, 0.f) & 0xffffu);
            }
        }
        asm volatile("s_waitcnt lgkmcnt(0)" ::: "memory");
        {
            const u32x4 hv = *(const LAS u32x4*)(ub + (32 * blk + (lane >> 1)) * 32 + (lane & 1) * 16);
            *(u32x4*)(HS + (tok0 + 32 * blk + (lane >> 1)) * TOKW + 16 * g + 8 * (lane & 1)) = hv;
        }
        asm volatile("s_waitcnt lgkmcnt(0)" ::: "memory");
    }
    __syncthreads();
}

template <int NC, int EB, bool BOUND>
DI void attn_core(LAS unsigned char* lds, const bf16_t* Q0, const bf16_t* Q1, int qpitch, const bf16_t* K0, const bf16_t* K1, int kpitch,
                  const bf16_t* Vt, int vpitch, int NT, int nvis, float negM, f32x16 (&o)[NC][EB], float (&l)[NC]) {
    int tid = tidx(); asm volatile("" : "+v"(tid));
    const int lane = tid & 63, wid = __builtin_amdgcn_readfirstlane(tid >> 6), r = lane & 31, hl = lane >> 5;
    constexpr int KB = 64 * 144, VB = EB * 32 * 144, BUF = NC * KB + VB, NV = EB / 2;
    constexpr int QP = NC * 128 + 16;
    LAS unsigned char* qreg = lds + 2 * BUF + wid * (32 * QP);
#pragma unroll
    for (int c = 0; c < NC; ++c)
#pragma unroll
        for (int i = 0; i < 4; ++i) { const int idx = lane + 64 * i;
            *(LAS u32x4*)(qreg + (idx >> 3) * QP + c * 128 + (idx & 7) * 16) = *(const u32x4*)((const char*)((c ? Q1 : Q0) + (size_t)(32 * wid) * qpitch) + (unsigned)(((idx >> 3) * qpitch + (idx & 7) * 8) * 2)); }
    const LAS unsigned char* qrd = qreg + r * QP + hl * 16;
#pragma unroll
    for (int c = 0; c < NC; ++c) { l[c] = 0.f;
#pragma unroll
        for (int eb = 0; eb < EB; ++eb)
#pragma unroll
            for (int i = 0; i < 16; ++i) o[c][eb][i] = 0.f; }
    const int krow = tid >> 3, kch = tid & 7;
    u32x4 sk[NC], sv[NV];
    const unsigned kvoff = (unsigned)(krow * kpitch + kch * 8) * 2u;
    unsigned vvoff[NV];
#pragma unroll
    for (int i = 0; i < NV; ++i) { const int idx = tid + 512 * i; vvoff[i] = (unsigned)((idx >> 3) * vpitch + (idx & 7) * 8) * 2u; }
#define ATT_GLOAD(kt) do { _Pragma("unroll") for (int c = 0; c < NC; ++c) sk[c] = *(const u32x4*)((const char*)((c ? K1 : K0) + (size_t)(kt) * 64 * kpitch) + kvoff); \
        _Pragma("unroll") for (int i = 0; i < NV; ++i) sv[i] = *(const u32x4*)((const char*)(Vt + (kt) * 64) + vvoff[i]); } while (0)
#define ATT_LSTORE(bi) do { LAS unsigned char* Bw = lds + (bi) * BUF; _Pragma("unroll") for (int c = 0; c < NC; ++c) *(LAS u32x4*)(Bw + c * KB + krow * 144 + kch * 16) = sk[c]; \
        _Pragma("unroll") for (int i = 0; i < NV; ++i) { const int idx = tid + 512 * i; *(LAS u32x4*)(Bw + NC * KB + (idx >> 3) * 144 + (idx & 7) * 16) = sv[i]; } } while (0)
    ATT_GLOAD(0); ATT_LSTORE(0); __syncthreads();
    const int pr = (r & ~12) | ((r & 4) << 1) | ((r & 8) >> 1);
#pragma nounroll
    for (int kt = 0; kt < NT; ++kt) {
        if (kt + 1 < NT) ATT_GLOAD(kt + 1);
        if (kt < nvis) {
            const LAS unsigned char* B = lds + (kt & 1) * BUF;
#pragma unroll
            for (int kb = 0; kb < 2; ++kb) {
                bf16x8 pf[NC][2];
#pragma unroll
                for (int c = 0; c < NC; ++c) {
                    f32x16 s;
#pragma unroll
                    for (int i = 0; i < 16; ++i) s[i] = 0.f;
#pragma unroll
                    for (int ds = 0; ds < 4; ++ds) { const bf16x8 kf = *(const LAS bf16x8*)(B + c * KB + (32 * kb + pr) * 144 + (16 * ds + 8 * hl) * 2); const bf16x8 qv = *(const LAS bf16x8*)(qrd + c * 128 + ds * 32); s = MFMA32(kf, qv, s); }
                    if (BOUND) {
#pragma unroll
                        for (int i = 0; i < 16; ++i) s[i] = __builtin_amdgcn_exp2f(s[i] + negM);
                    } else {
#pragma unroll
                        for (int i = 0; i < 16; ++i) s[i] = __builtin_amdgcn_exp2f(s[i]);
                    }
                    {
                        float ls;
                        asm("s_nop 0\n\tv_add_f32_e32 %0, %1, %2\n\tv_add_f32_e32 %0, %0, %3\n\tv_add_f32_e32 %0, %0, %4\n\tv_add_f32_e32 %0, %0, %5\n\tv_add_f32_e32 %0, %0, %6\n\tv_add_f32_e32 %0, %0, %7\n\tv_add_f32_e32 %0, %0, %8\n\tv_add_f32_e32 %0, %0, %9\n\t"
                            "v_add_f32_e32 %0, %0, %10\n\tv_add_f32_e32 %0, %0, %11\n\tv_add_f32_e32 %0, %0, %12\n\tv_add_f32_e32 %0, %0, %13\n\tv_add_f32_e32 %0, %0, %14\n\tv_add_f32_e32 %0, %0, %15\n\tv_add_f32_e32 %0, %0, %16"
                            : "=&v"(ls) : "v"(s[0]), "v"(s[1]), "v"(s[2]), "v"(s[3]), "v"(s[4]), "v"(s[5]), "v"(s[6]), "v"(s[7]), "v"(s[8]), "v"(s[9]), "v"(s[10]), "v"(s[11]), "v"(s[12]), "v"(s[13]), "v"(s[14]), "v"(s[15]));
                        l[c] += ls;
                    }
                    u32x4 w0, w1;
                    w0.x = cvtpk(s[0], s[1]); w0.y = cvtpk(s[2], s[3]); w0.z = cvtpk(s[4], s[5]); w0.w = cvtpk(s[6], s[7]);
                    w1.x = cvtpk(s[8], s[9]); w1.y = cvtpk(s[10], s[11]); w1.z = cvtpk(s[12], s[13]); w1.w = cvtpk(s[14], s[15]);
                    pf[c][0] = __builtin_bit_cast(bf16x8, w0); pf[c][1] = __builtin_bit_cast(bf16x8, w1);
                    __builtin_amdgcn_sched_barrier(0);
                }
#pragma unroll
                for (int eb = 0; eb < EB; ++eb)
#pragma unroll
                    for (int s2 = 0; s2 < 2; ++s2) {
                        const bf16x8 vf = *(const LAS bf16x8*)(B + NC * KB + (32 * eb + r) * 144 + (32 * kb + 16 * s2 + 8 * hl) * 2);
#pragma unroll
                        for (int c = 0; c < NC; ++c) o[c][eb] = MFMA32(vf, pf[c][s2], o[c][eb]);
                        __builtin_amdgcn_sched_barrier(0);
                    }
            }
        }
        if (kt + 1 < NT) ATT_LSTORE((kt + 1) & 1);
        __syncthreads();
    }
#undef ATT_GLOAD
#undef ATT_LSTORE
}

DI void diff_unit(LAS unsigned char* lds, ArgsP a, int j, int layer, int bh, int qb) {
    const int tid = tidx(), lane = tid & 63, wid = __builtin_amdgcn_readfirstlane(tid >> 6);
    const int b = bh / 6, h = bh % 6;
    unsigned char* ws = a->ws;
    const bf16_t* Z = (const bf16_t*)(ws + WS_Z + (size_t)b * Z_GAP); const bf16_t* KD = (const bf16_t*)(ws + WS_KD); const bf16_t* VT = (const bf16_t*)(ws + WS_VT);
    bf16_t* CAT = (bf16_t*)(ws + WS_CAT + (size_t)b * CAT_GAP);
    const float gqk = fabsf(a->in[I_DQN][j * 64 + lane] * a->in[I_DKN][lane]);
    const float negM = -8.0f * LOG2E * wave_max(gqk);
    const float s1 = wave_sum(a->in[I_LQ1][j * 64 + lane] * a->in[I_LK1][j * 64 + lane]), s2 = wave_sum(a->in[I_LQ2][j * 64 + lane] * a->in[I_LK2][j * 64 + lane]);
    const float lambda_init = 0.8f - 0.6f * expf(-0.3f * (float)layer);
    const float lam = expf(s1) - expf(s2) + lambda_init;
    f32x16 o[2][4]; float l[2];
    const bf16_t* Q0 = Z + ((size_t)b * SEQ + 256 * qb) * DM + h * 64;
    const bf16_t* K0 = KD + ((size_t)b * SEQ) * TOKW + h * 64;
    if (negM < -64.0f) attn_core<2, 4, true>(lds, Q0, Q0 + 384, DM, K0, K0 + 384, TOKW, VT + ((size_t)(b * 6 + h) * 128) * SEQ, SEQ, 4 * qb + 4, 4 * qb + (wid >> 1) + 1, negM, o, l);
    else attn_core<2, 4, false>(lds, Q0, Q0 + 384, DM, K0, K0 + 384, TOKW, VT + ((size_t)(b * 6 + h) * 128) * SEQ, SEQ, 4 * qb + 4, 4 * qb + (wid >> 1) + 1, 0.f, o, l);
    int lane2 = tidx() & 63; asm volatile("" : "+v"(lane2));
    const int r = lane2 & 31, hl = lane2 >> 5;
    const float l0 = l[0] + __shfl_xor(l[0], 32), l1 = l[1] + __shfl_xor(l[1], 32);
    const float inv0 = 1.0f / l0, inv1 = lam / l1;
    float ss = 0.f;
#pragma unroll
    for (int eb = 0; eb < 4; ++eb)
#pragma unroll
        for (int i = 0; i < 16; ++i) { const float v = o[0][eb][i] * inv0 - o[1][eb][i] * inv1; o[0][eb][i] = v; ss += v * v; }
    ss += __shfl_xor(ss, 32);
    const float rn = rsqrtf(ss * (1.0f / 128.0f) + EPS) * (1.0f - lambda_init);
    const float* sg = a->in[I_SUBN] + j * 128;
    char* opb = (char*)(CAT + ((size_t)b * SEQ + 256 * qb + 32 * wid) * DM + h * 128);
    const unsigned ooff = (unsigned)(r * DM + 4 * hl) * 2u;
#pragma unroll
    for (int eb = 0; eb < 4; ++eb)
#pragma unroll
        for (int a4 = 0; a4 < 4; ++a4) {
            const f32x4 g = *(const f32x4*)((const char*)(sg + 32 * eb + 8 * a4) + (unsigned)(hl * 16));
            u32x2 w; w.x = cvtpk(o[0][eb][4 * a4] * rn * g[0], o[0][eb][4 * a4 + 1] * rn * g[1]); w.y = cvtpk(o[0][eb][4 * a4 + 2] * rn * g[2], o[0][eb][4 * a4 + 3] * rn * g[3]);
            *(u32x2*)(opb + (32 * eb + 8 * a4) * 2 + ooff) = w;
        }
}
DI void mem_unit(LAS unsigned char* lds, ArgsP a, int layer, int unit) {
    const int tid = tidx(), lane = tid & 63, wid = __builtin_amdgcn_readfirstlane(tid >> 6);
    const int b = unit >> 5, hm = (unit >> 3) & 3, qb = unit & 7;
    unsigned char* ws = a->ws;
    const bf16_t* Z = (const bf16_t*)(ws + WS_Z + (size_t)b * Z_GAP); bf16_t* CAT = (bf16_t*)(ws + WS_CAT + (size_t)b * CAT_GAP);
    const bf16_t* MK = (const bf16_t*)(ws + WS_MEMK) + (size_t)layer * MMEM * 256; const bf16_t* MV = (const bf16_t*)(ws + WS_MEMVT) + (size_t)layer * MMEM * 256;
    const float gqk = fabsf(a->in[I_MQN][layer * 64 + lane] * a->in[I_MKN][layer * 64 + lane]);
    const float negM = -8.0f * LOG2E * wave_max(gqk);
    f32x16 o[1][2]; float l[1];
    const bf16_t* Q0 = Z + ((size_t)b * SEQ + 256 * qb) * DM + 768 + hm * 64;
    const bf16_t* K0 = MK + ((size_t)b * NMEM) * 256 + hm * 64;
    if (negM < -64.0f) attn_core<1, 2, true>(lds, Q0, Q0, DM, K0, K0, 256, MV + ((size_t)(b * 4 + hm) * 64) * NMEM, NMEM, 4, 4, negM, o, l);
    else attn_core<1, 2, false>(lds, Q0, Q0, DM, K0, K0, 256, MV + ((size_t)(b * 4 + hm) * 64) * NMEM, NMEM, 4, 4, 0.f, o, l);
    int lane2 = tidx() & 63; asm volatile("" : "+v"(lane2));
    const int r = lane2 & 31, hl = lane2 >> 5;
    const float inv = 1.0f / (l[0] + __shfl_xor(l[0], 32));
    char* opb = (char*)(CAT + ((size_t)b * SEQ + 256 * qb + 32 * wid) * DM + 768 + hm * 64);
    const unsigned ooff = (unsigned)(r * DM + 4 * hl) * 2u;
#pragma unroll
    for (int eb = 0; eb < 2; ++eb)
#pragma unroll
        for (int a4 = 0; a4 < 4; ++a4) {
            u32x2 w; w.x = cvtpk(o[0][eb][4 * a4] * inv, o[0][eb][4 * a4 + 1] * inv); w.y = cvtpk(o[0][eb][4 * a4 + 2] * inv, o[0][eb][4 * a4 + 3] * inv);
            *(u32x2*)(opb + (32 * eb + 8 * a4) * 2 + ooff) = w;
        }
}

#define XB_TMO      128
#define XB_XCNT(j)  (256  + 64 * (j))
#define XB_XSUB(j)  (1280 + 64 * (j))
#define XB_XGEN(j)  (2304 + 64 * (j))
#define XB_TOP      3328
#define XB_TOPGEN   3392
#define XCD_BAR_WORDS 3456
#define XB_SPIN_CAP (1u << 18)

__device__ __forceinline__ unsigned xb_ld(unsigned* p)              { return __hip_atomic_load(p, __ATOMIC_RELAXED, __HIP_MEMORY_SCOPE_AGENT); }
__device__ __forceinline__ unsigned xb_add(unsigned* p, unsigned v) { return __hip_atomic_fetch_add(p, v, __ATOMIC_RELAXED, __HIP_MEMORY_SCOPE_AGENT); }
__device__ __forceinline__ unsigned xb_xcc_id() { return (unsigned)__builtin_amdgcn_s_getreg((3 << 11) | 20) & 0xFu; }
#define XB_SPIN(cond, bar) do { unsigned _sp = 0; while (cond) { __builtin_amdgcn_s_sleep(1); \
    if ((++_sp & 255u) == 0u) { if (xb_ld(&(bar)[XB_TMO])) break; if (_sp > XB_SPIN_CAP) { atomicAdd(&(bar)[XB_TMO], 1u); break; } } } } while (0)

struct XcdBarrier {
    unsigned* bar; unsigned x;
    volatile LAS unsigned* st;
};

__device__ __forceinline__ XcdBarrier xcd_barrier_post(unsigned* bar, volatile LAS unsigned* st) {
    XcdBarrier b; b.bar = bar; b.x = xb_xcc_id(); b.st = st;
    if (tidx() == 0) (void)xb_add(&bar[XB_XCNT(b.x)], 1u);
    return b;
}
__device__ __forceinline__ void xcd_barrier_complete(unsigned* bar, unsigned x, unsigned& nloc, unsigned& nx) {
    const unsigned G = gridDim.x * gridDim.y * gridDim.z;
    unsigned sum, cnt, mine, sp = 0u;
    for (;;) {
        sum = 0u; cnt = 0u; mine = 0u;
#pragma unroll
        for (unsigned j = 0; j < 16; ++j) { const unsigned c = xb_ld(&bar[XB_XCNT(j)]); sum += c; cnt += (c > 0u) ? 1u : 0u; mine = (j == x) ? c : mine; }
        if (sum == G) break;
        __builtin_amdgcn_s_sleep(1);
        if ((++sp & 255u) == 0u) { if (xb_ld(&bar[XB_TMO])) break; if (sp > XB_SPIN_CAP) { atomicAdd(&bar[XB_TMO], 1u); break; } }
    }
    nloc = mine > 0u ? mine : 1u; nx = cnt > 0u ? cnt : 1u;
}

__device__ __forceinline__ void xcd_barrier(const XcdBarrier& b) {
    asm volatile("s_waitcnt vmcnt(0)" ::: "memory");
    __syncthreads();
    if (tidx() == 0) {
        unsigned* bar = b.bar;
        __builtin_amdgcn_s_waitcnt(0);
        unsigned nloc = b.st[0], nx = b.st[1];
        if (nloc == 0u) { xcd_barrier_complete(bar, b.x, nloc, nx); b.st[0] = nloc; b.st[1] = nx; }
        const unsigned old = xb_add(&bar[XB_XSUB(b.x)], 1u);
        const unsigned gen = old / nloc;
        if (old + 1u == (gen + 1u) * nloc) {
            __builtin_amdgcn_fence(__ATOMIC_RELEASE, "agent");
            asm volatile("s_waitcnt vmcnt(0)" ::: "memory");
            const unsigned og = xb_add(&bar[XB_TOP], 1u);
            const unsigned tg = og / nx;
            if (og + 1u == (tg + 1u) * nx) xb_add(&bar[XB_TOPGEN], 1u);
            else XB_SPIN(xb_ld(&bar[XB_TOPGEN]) == tg, bar);
            __builtin_amdgcn_fence(__ATOMIC_ACQUIRE, "agent");
            xb_add(&bar[XB_XGEN(b.x)], 1u);
            asm volatile("s_waitcnt vmcnt(0)" ::: "memory");
        } else {
            XB_SPIN(xb_ld(&bar[XB_XGEN(b.x)]) == gen, bar);
            __builtin_amdgcn_fence(__ATOMIC_ACQUIRE, "agent");
            asm volatile("s_waitcnt vmcnt(0)" ::: "memory");
        }
    }
    __syncthreads();
}

#define GB_SUB(g)  (4096 + 128 * (g))
#define GB_GEN(g)  (4096 + 128 * (g) + 64)
#define GB_MASK(g) (5120 + 64 * (g))
DI void group_barrier(unsigned* bar, volatile LAS unsigned* st) {
    asm volatile("s_waitcnt vmcnt(0)" ::: "memory");
    __syncthreads();
    if (tidx() == 0) {
        const unsigned g = blockIdx.x & 7u;
        unsigned fast = st[2];
        if (fast == 0u) { const unsigned m = xb_ld(&bar[GB_MASK(g)]); fast = ((m & (m - 1u)) == 0u) ? 1u : 2u; st[2] = fast; }
        if (fast != 1u) { __builtin_amdgcn_fence(__ATOMIC_RELEASE, "agent"); asm volatile("s_waitcnt vmcnt(0)" ::: "memory"); }
        const unsigned old = xb_add(&bar[GB_SUB(g)], 1u);
        const unsigned gen = old / 32u;
        if (old + 1u == (gen + 1u) * 32u) xb_add(&bar[GB_GEN(g)], 1u);
        else XB_SPIN(xb_ld(&bar[GB_GEN(g)]) == gen, bar);
        __builtin_amdgcn_fence(__ATOMIC_ACQUIRE, "agent");
        asm volatile("s_waitcnt vmcnt(0)" ::: "memory");
    }
    __syncthreads();
}

constexpr int NPH = 24;
enum { PK_PRO = 0, PK_Z, PK_MEMKV, PK_MIX, PK_GLU, PK_OUT, PK_GU, PK_DOWN };
DI void decode_phase(int ph, int& kind, int& layer) {
    if (ph == 0) { kind = PK_PRO; layer = 0; return; }
    if (ph < 8) { layer = 0; const int k = ph - 1; kind = k == 0 ? PK_Z : k == 1 ? PK_MEMKV : k == 2 ? PK_MIX : k == 3 ? PK_GLU : k == 4 ? PK_OUT : k == 5 ? PK_GU : PK_DOWN; return; }
    if (ph < 14) { layer = 1; const int k = ph - 8; kind = k == 0 ? PK_Z : k == 1 ? PK_MIX : k == 2 ? PK_GLU : k == 3 ? PK_OUT : k == 4 ? PK_GU : PK_DOWN; return; }
    layer = ph < 19 ? 2 : 3; const int k = ph - (ph < 19 ? 14 : 19); kind = k == 0 ? PK_Z : k == 1 ? PK_MIX : k == 2 ? PK_OUT : k == 3 ? PK_GU : PK_DOWN;
}

__global__ void __launch_bounds__(NTHREADS) mk_fwd(Args a_by_value) {
    extern __shared__ __attribute__((aligned(16))) unsigned char lds_raw[];
    LAS unsigned char* lds = (LAS unsigned char*)lds_raw;
    ArgsP a = (ArgsP)__builtin_amdgcn_kernarg_segment_ptr();
    const int ph_hi = a->ph_hi;
    if (ph_hi - a->ph_lo > 1) { volatile LAS unsigned* bst = (volatile LAS unsigned*)(lds + LDS_BYTES - 64); if (tidx() < 16) bst[tidx()] = 0u; __syncthreads(); (void)xcd_barrier_post((unsigned*)(a->ws + WS_BAR), bst); if (tidx() == 0) (void)__hip_atomic_fetch_or((unsigned*)(a->ws + WS_BAR) + GB_MASK(blockIdx.x & 7u), 1u << xb_xcc_id(), __ATOMIC_RELAXED, __HIP_MEMORY_SCOPE_AGENT); }
    int repeated = 0;
#pragma nounroll
    for (int ph = a->ph_lo; ph < ph_hi; ++ph) {
        asm volatile("" : "+s"(a));
        unsigned char* ws = a->ws;
        int kind, layer; decode_phase(ph, kind, layer);
        if (kind == PK_PRO) {
#ifndef NO_PRO
            prologue(a, lds);
#endif
        } else if (kind == PK_MIX) {
            const int bx = blockIdx.x & 7, jw = blockIdx.x >> 3;
            if (layer < 2) {
#ifndef NO_SSM
                for (int g = jw; g < 48; g += 32)
                    ssm_unit(lds, layer, bx, g, (const bf16_t*)(ws + WS_Z + (size_t)bx * Z_GAP), (bf16_t*)(ws + WS_HSSM + (size_t)bx * HS_GAP), (const float*)(ws + WS_ABAR), (const bf16_t*)(ws + WS_BBT), (const bf16_t*)(ws + WS_CT), a->in[I_SD] + layer * TOKW);
#endif
#ifndef NO_MEM
                if (jw >= 16) { for (int i = 0; i < 2; ++i) mem_unit(lds, a, layer, bx * 32 + 2 * (jw - 16) + i); }
#endif
            } else {
#ifndef NO_DIFF
                const int j = layer - 2;
                if (jw < 30) {
                    const int grp = jw / 6, h = jw % 6;
                    const int nun = grp < 2 ? 1 : 2;
                    for (int i = 0; i < nun; ++i) { const int qb = i == 0 ? 7 - grp : grp - 2; diff_unit(lds, a, j, layer, bx * 6 + h, qb); }
                }
                { const int m0 = jw < 6 ? 0 : jw < 30 ? (jw - 6) : 24 + 4 * (jw - 30), nm = jw < 6 ? 0 : jw < 30 ? 1 : 4;
                  for (int i = 0; i < nm; ++i) mem_unit(lds, a, layer, bx * 32 + m0 + i); }
#endif
            }
        } else {
            pg8::Gemm g; Epi E{}; E.a = a; E.layer = layer; E.xl = lds + 131072;
            if (kind == PK_Z) { g = pg8::Gemm{(const bf16_t*)(ws + WS_XB), (const bf16_t*)(ws + w_in_off(layer)), MT, layer == 2 ? 2560 : 1024, DM}; E.mode = 0; }
            else if (kind == PK_MEMKV) { g = pg8::Gemm{(const bf16_t*)(ws + WS_MEMB), (const bf16_t*)(ws + WS_WMEMKV), MMEM, 2048, DM}; E.mode = 1; }
            else if (kind == PK_GLU) { g = pg8::Gemm{(const bf16_t*)(ws + WS_HSSM), (const bf16_t*)(ws + w_glu_off(layer)), MT, TOKW, TOKW, HS_GAP}; E.mode = 2; }
            else if (kind == PK_OUT) { g = pg8::Gemm{(const bf16_t*)(ws + WS_CAT), (const bf16_t*)(ws + w_out_off(layer)), MT, DM, DM, CAT_GAP}; E.mode = 3; E.sub = 0; }
            else if (kind == PK_GU) { g = pg8::Gemm{(const bf16_t*)(ws + WS_XB), (const bf16_t*)(ws + w_gu_off(layer)), MT, 2 * DFF, DM}; E.mode = 4; }
            else { g = pg8::Gemm{(const bf16_t*)(ws + WS_HID), (const bf16_t*)(ws + w_d_off(layer)), MT, DM, DFF}; E.mode = 3; E.sub = 1; }
            pg8::StaticOrder S; S.init(g.M, g.N, (int)gridDim.x, (int)blockIdx.x);
#ifndef NO_GEMM
            pg8::gemm_phase<Epi, pg8::StaticOrder, true, true>(lds, g, S, E);
#endif
            if (kind == PK_MEMKV && blockIdx.x >= 64) conv_layer(a, lds, 0, 512, 1 << 30, ((int)blockIdx.x - 64) * NWAVES + __builtin_amdgcn_readfirstlane(tidx() >> 6), 192 * NWAVES);
            if (kind == PK_GU && layer < 3 && blockIdx.x >= 128) conv_layer(a, lds, layer + 1, 0, 1 << 30, ((int)blockIdx.x - 128) * NWAVES + __builtin_amdgcn_readfirstlane(tidx() >> 6), 128 * NWAVES);
        }
        if (ph + 1 < ph_hi && ph != 1) {
            if (ph_hi < 0) cg::this_grid().sync();
            volatile LAS unsigned* bst = (volatile LAS unsigned*)(lds + LDS_BYTES - 64);
            if (kind == PK_PRO || kind == PK_MEMKV || kind == PK_DOWN || gridDim.x != 256u) { XcdBarrier bar; bar.bar = (unsigned*)(a->ws + WS_BAR); bar.x = xb_xcc_id(); bar.st = bst; xcd_barrier(bar); }
            else group_barrier((unsigned*)(a->ws + WS_BAR), bst);
        }
        if (REP_KIND >= 0) { if (kind == REP_KIND && ((REP_LAYERS >> layer) & 1) && !repeated) { repeated = 1; --ph; } else repeated = 0; }
    }
}

extern "C" void kernel_launch(void* const* d_in, const int* in_sizes, int n_in, void* d_out, int out_size, void* d_ws, size_t ws_size, hipStream_t stream) {
    static int grid = 0;
    if (grid == 0) {
        if (n_in != N_IN || out_size != MT * DM || ws_size < WS_END) { fprintf(stderr, "kernel_launch: unexpected problem (n_in %d, out %d, ws %zu; need ws >= %zu)\n", n_in, out_size, ws_size, (size_t)WS_END); grid = -1; return; }
        if (hipFuncSetAttribute((const void*)mk_fwd, hipFuncAttributeMaxDynamicSharedMemorySize, LDS_BYTES) != hipSuccess) { fprintf(stderr, "kernel_launch: hipFuncSetAttribute failed\n"); grid = -1; return; }
        int dev = 0, cus = 0, per_cu = 0;
        hipGetDevice(&dev); hipDeviceGetAttribute(&cus, hipDeviceAttributeMultiprocessorCount, dev);
        hipOccupancyMaxActiveBlocksPerMultiprocessor(&per_cu, (const void*)mk_fwd, NTHREADS, LDS_BYTES);
        if (per_cu < 1 || cus < 256) { fprintf(stderr, "kernel_launch: occupancy %d per CU, %d CUs: need >= 1 and 256\n", per_cu, cus); grid = -1; return; }
        grid = 256;
    }
    if (grid < 0) return;
    Args a{};
    for (int i = 0; i < N_IN; ++i) a.in[i] = (const float*)d_in[i];
    a.out = (float*)d_out; a.ws = (unsigned char*)d_ws;
    a.dc0 = 0.15915494309189533577; a.dc1 = 6.283185307179586; a.dc2 = 2.4492935982947064e-16; a.ione = 1;
#if MK_MULTI
    for (int ph = 0; ph < NPH; ++ph) { a.ph_lo = ph; a.ph_hi = ph + 1; hipLaunchKernelGGL(mk_fwd, dim3(grid), dim3(NTHREADS), LDS_BYTES, stream, a); }
#else
    a.ph_lo = 0; a.ph_hi = NPH;
    if (hipMemsetAsync((char*)d_ws + WS_BAR, 0, BAR_ZERO_BYTES, stream) != hipSuccess) { fprintf(stderr, "kernel_launch: memset failed\n"); return; }
    void* args[] = {&a};
    hipError_t e = hipLaunchCooperativeKernel((const void*)mk_fwd, dim3(grid), dim3(NTHREADS), args, LDS_BYTES, stream);
    if (e != hipSuccess) fprintf(stderr, "kernel_launch: cooperative launch failed: %s\n", hipGetErrorString(e));
#endif
}
```

```cpp
#include <hip/hip_runtime.h>
#include <hip/hip_cooperative_groups.h>
#include <cstdio>
#include <cstdint>
namespace cg = cooperative_groups;
#ifndef MK_MULTI
#define MK_MULTI 0
#endif
__device__ __forceinline__ int tidx() { int t = threadIdx.x; asm volatile("" : "+v"(t)); return t; }
namespace pg8 {
#define PG8_LAS __attribute__((address_space(3)))
typedef unsigned short bf16_t;
typedef short bf16x8 __attribute__((ext_vector_type(8)));
typedef float f32x4 __attribute__((ext_vector_type(4)));
typedef unsigned u32x4 __attribute__((ext_vector_type(4)));
constexpr int BM = 256, BK = 64, HALF = 128, HTB = HALF * BK * 2  , STAGE_BYTES = 8 * HTB, NXCD = 8, WGM = 8;

__host__ __device__ __forceinline__ int lds_byte(int r, int c) { const int st = (r >> 4) * 2 + (c >> 5), rr = r & 15, cc = c & 31, ob = rr * 64 + cc * 2; return st * 1024 + (ob ^ (((ob >> 9) & 1) << 5)); }
__host__ __device__ __forceinline__ void stage_rc(int b, int& R, int& C) { const int st = b / 1024, sb = b % 1024, swz = sb ^ (((sb >> 9) & 1) << 5); R = (st >> 1) * 16 + swz / 64; C = (st & 1) * 32 + (swz % 64) / 2; }
__host__ __device__ __forceinline__ int perm32(int rho) { const int n = rho >> 4, i = rho & 15; return 8 * (i >> 2) + 4 * n + (i & 3); }

struct Unit { int pm, pn; };
struct Gemm { const bf16_t* A; const bf16_t* Bt; int M, N, K; size_t a_gap; };

struct StaticOrder {
    int nM, nN, nwg, G, c;
    __host__ __device__ void init(int M, int N, int G_, int c_) { nM = M / BM; nN = N / BM; nwg = nM * nN; G = G_; c = c_; }
    __host__ __device__ bool next(int i, Unit& u) const {
        const long L = (long)i * G + c; if (L >= nwg) return false;
        int wgid = (int)L; { const int q = nwg / NXCD, r = nwg % NXCD, xcd = wgid % NXCD, off = wgid / NXCD; wgid = (xcd < r ? xcd * (q + 1) : r * (q + 1) + (xcd - r) * q) + off; }
        const int nig = WGM * nN, gid = wgid / nig, fm = gid * WGM, gsz = (nM - fm) < WGM ? (nM - fm) : WGM;
        u.pm = fm + ((wgid % nig) % gsz); u.pn = (wgid % nig) / gsz; return true;
    }
    __device__ __forceinline__ void a_ready(const Unit&) const {}
    __device__ __forceinline__ void done(const Unit&) const {}
};

__device__ __forceinline__ unsigned cvt_pk_bf16(float lo, float hi) { unsigned r; asm volatile("v_cvt_pk_bf16_f32 %0, %1, %2" : "=v"(r) : "v"(lo), "v"(hi)); return r; }
typedef float f32x2 __attribute__((ext_vector_type(2)));
template <class Epi, class Sched, bool ALIGN_EPI = false, bool SP2 = false>
__device__ __forceinline__ void gemm_phase(PG8_LAS unsigned char* lds, const Gemm g, const Sched& S, const Epi& E) {
    const int tid = tidx(), wid = __builtin_amdgcn_readfirstlane(tid >> 6), lane = tid & 63, wr = wid >> 2, wc = wid & 3, fr = lane & 15, fq = lane >> 4;
    const int K = g.K, nt = K / BK;
    unsigned voffA[2], voffB[2];
#pragma unroll
    for (int i = 0; i < 2; ++i) { int R, C; stage_rc(tid * 16 + i * 8192, R, C); const int Rb = Epi::PERM ? ((R & ~31) + perm32(R & 31)) : R;
        voffA[i] = (unsigned)(R * K + C) * 2u; voffB[i] = (unsigned)(Rb * K + C) * 2u; }
    const size_t kstep = (size_t)(BK * 2);
    const size_t hstep = (size_t)HALF * K * 2;
    const size_t tstep = 2 * hstep;
    const unsigned ldsw = (unsigned)wid * 1024u;
    const int aoff = lds_byte(wr * 64 + fr, fq * 8), boff = lds_byte(wc * 32 + fr, fq * 8);
#define PG8_SA(b, h) (((b) * 2 + (h)) * HTB)
#define PG8_SB(b, h) ((4 + (b) * 2 + (h)) * HTB)
#define PG8_STAGE(bufoff, gbase, voff) do { _Pragma("unroll") for (int _i = 0; _i < 2; ++_i) \
        __builtin_amdgcn_global_load_lds((const unsigned*)((const char*)(gbase) + (voff)[_i]), (PG8_LAS unsigned*)(lds + (bufoff) + ldsw + _i * 8192), 16, 0, 0); } while (0)
#define PG8_LDA(dst, b, h) do { _Pragma("unroll") for (int m = 0; m < 4; ++m) _Pragma("unroll") for (int k = 0; k < 2; ++k) dst[m][k] = *(const PG8_LAS bf16x8*)(lds + PG8_SA(b, h) + aoff + m * 2048 + k * 1024); } while (0)
#define PG8_LDB(dst, b, h) do { _Pragma("unroll") for (int n = 0; n < 2; ++n) _Pragma("unroll") for (int k = 0; k < 2; ++k) dst[n][k] = *(const PG8_LAS bf16x8*)(lds + PG8_SB(b, h) + boff + n * 2048 + k * 1024); } while (0)
#define PG8_MMA(ai, bj, At, Bt) do { __builtin_amdgcn_s_setprio(1); _Pragma("unroll") for (int m = 0; m < 4; ++m) _Pragma("unroll") for (int n = 0; n < 2; ++n) _Pragma("unroll") for (int k = 0; k < 2; ++k) \
        acc[ai][bj][m][n] = __builtin_amdgcn_mfma_f32_16x16x32_bf16(Bt[n][k], At[m][k], acc[ai][bj][m][n], 0, 0, 0); __builtin_amdgcn_s_setprio(0); } while (0)
#define PG8_WAIT_V(n) asm volatile("s_waitcnt vmcnt(" #n ")" ::: "memory")
#define PG8_WAIT_L(n) asm volatile("s_waitcnt lgkmcnt(" #n ")" ::: "memory")
#define PG8_BAR __builtin_amdgcn_s_barrier()
#define PG8_SCHED __builtin_amdgcn_sched_barrier(0)
    Unit cur, nxt; int ui = 0;
    if (!S.next(0, cur)) return;
    f32x4 acc[2][2][4][2];
#pragma unroll
    for (int a = 0; a < 2; ++a)
#pragma unroll
        for (int b = 0; b < 2; ++b)
#pragma unroll
            for (int m = 0; m < 4; ++m)
#pragma unroll
                for (int n = 0; n < 2; ++n) acc[a][b][m][n] = (f32x4){0.f, 0.f, 0.f, 0.f};
    bf16x8 At[4][2], B0[2][2], B1[2][2];
    const char* cA = (const char*)g.A + (size_t)cur.pm * tstep + (size_t)(cur.pm >> 3) * g.a_gap; const char* cB = (const char*)g.Bt + (size_t)cur.pn * tstep;
    S.a_ready(cur);
    if constexpr (SP2) {
        PG8_STAGE(PG8_SB(0, 0), cB, voffB); PG8_STAGE(PG8_SB(0, 1), cB + hstep, voffB); PG8_STAGE(PG8_SA(0, 0), cA, voffA); PG8_STAGE(PG8_SA(0, 1), cA + hstep, voffA);
        if (wr == 1) PG8_BAR;
        PG8_WAIT_V(2); PG8_BAR;
        PG8_STAGE(PG8_SB(1, 0), cB + kstep, voffB); PG8_STAGE(PG8_SA(1, 0), cA + kstep, voffA); PG8_STAGE(PG8_SB(1, 1), cB + hstep + kstep, voffB);
        PG8_WAIT_V(6); PG8_BAR;
    } else {
        PG8_STAGE(PG8_SB(0, 0), cB, voffB); PG8_STAGE(PG8_SA(0, 0), cA, voffA); PG8_STAGE(PG8_SB(0, 1), cB + hstep, voffB); PG8_STAGE(PG8_SA(0, 1), cA + hstep, voffA);
        if (wr == 1) PG8_BAR;
        PG8_WAIT_V(4); PG8_BAR;
        PG8_STAGE(PG8_SB(1, 0), cB + kstep, voffB); PG8_STAGE(PG8_SA(1, 0), cA + kstep, voffA); PG8_STAGE(PG8_SB(1, 1), cB + hstep + kstep, voffB);
        PG8_WAIT_V(6); PG8_BAR;
    }
    for (;;) {
        const bool has_next = S.next(ui + 1, nxt);
        const char* nA = has_next ? (const char*)g.A + (size_t)nxt.pm * tstep + (size_t)(nxt.pm >> 3) * g.a_gap : cA; const char* nB = has_next ? (const char*)g.Bt + (size_t)nxt.pn * tstep : cB;
        for (int t = 0; t < nt; t += 2) {
            const bool last = (t == nt - 2);
            const char* a1 = cA + (size_t)(t + 1) * kstep;
            const char* a2 = last ? nA : cA + (size_t)(t + 2) * kstep; const char* b2 = last ? nB : cB + (size_t)(t + 2) * kstep;
            const char* a3 = a2 + kstep; const char* b3 = b2 + kstep;
            if (last && has_next) S.a_ready(nxt);
            if constexpr (SP2) {
            PG8_LDB(B0, 0, 0); PG8_LDB(B1, 0, 1); PG8_SCHED; PG8_LDA(At, 0, 0); PG8_STAGE(PG8_SA(1, 1), a1 + hstep, voffA);
            PG8_WAIT_V(8); PG8_WAIT_L(0); PG8_BAR; PG8_MMA(0, 0, At, B0); PG8_MMA(0, 1, At, B1); PG8_BAR; PG8_SCHED;
            PG8_LDA(At, 0, 1); PG8_STAGE(PG8_SB(0, 0), b2, voffB); PG8_STAGE(PG8_SB(0, 1), b2 + hstep, voffB); PG8_STAGE(PG8_SA(0, 0), a2, voffA);
            PG8_WAIT_V(8); PG8_WAIT_L(0); PG8_BAR; PG8_MMA(1, 0, At, B0); PG8_MMA(1, 1, At, B1); PG8_BAR; PG8_SCHED;
            PG8_LDB(B0, 1, 0); PG8_LDB(B1, 1, 1); PG8_SCHED; PG8_LDA(At, 1, 0); PG8_STAGE(PG8_SA(0, 1), a2 + hstep, voffA);
            PG8_WAIT_V(8); PG8_WAIT_L(0); PG8_BAR; PG8_MMA(0, 0, At, B0); PG8_MMA(0, 1, At, B1); PG8_BAR; PG8_SCHED;
            PG8_LDA(At, 1, 1); PG8_STAGE(PG8_SB(1, 0), b3, voffB); PG8_STAGE(PG8_SB(1, 1), b3 + hstep, voffB); PG8_STAGE(PG8_SA(1, 0), a3, voffA);
            PG8_WAIT_V(8); PG8_WAIT_L(0); PG8_BAR; PG8_MMA(1, 0, At, B0); PG8_MMA(1, 1, At, B1); PG8_BAR; PG8_SCHED;
            } else {
            PG8_LDB(B0, 0, 0); PG8_SCHED; PG8_LDA(At, 0, 0); PG8_STAGE(PG8_SA(1, 1), a1 + hstep, voffA);
            PG8_WAIT_L(8); PG8_BAR; PG8_WAIT_L(0); PG8_MMA(0, 0, At, B0); PG8_BAR; PG8_SCHED;
            PG8_LDB(B1, 0, 1); PG8_STAGE(PG8_SB(0, 0), b2, voffB);
            PG8_BAR; PG8_WAIT_L(0); PG8_MMA(0, 1, At, B1); PG8_BAR;
            PG8_LDA(At, 0, 1); PG8_STAGE(PG8_SA(0, 0), a2, voffA);
            PG8_BAR; PG8_WAIT_L(0); PG8_MMA(1, 0, At, B0); PG8_BAR; PG8_SCHED;
            PG8_STAGE(PG8_SB(0, 1), b2 + hstep, voffB);
            PG8_WAIT_V(6); PG8_BAR; PG8_MMA(1, 1, At, B1); PG8_BAR;
            PG8_LDB(B0, 1, 0); PG8_SCHED; PG8_LDA(At, 1, 0); PG8_STAGE(PG8_SA(0, 1), a2 + hstep, voffA);
            PG8_WAIT_L(8); PG8_BAR; PG8_WAIT_L(0); PG8_MMA(0, 0, At, B0); PG8_BAR; PG8_SCHED;
            PG8_LDB(B1, 1, 1); PG8_STAGE(PG8_SB(1, 0), b3, voffB);
            PG8_BAR; PG8_WAIT_L(0); PG8_MMA(0, 1, At, B1); PG8_BAR;
            PG8_LDA(At, 1, 1); PG8_STAGE(PG8_SA(1, 0), a3, voffA);
            PG8_BAR; PG8_WAIT_L(0); PG8_MMA(1, 0, At, B0); PG8_BAR; PG8_SCHED;
            PG8_STAGE(PG8_SB(1, 1), b3 + hstep, voffB);
            PG8_WAIT_V(6); PG8_BAR; PG8_MMA(1, 1, At, B1); PG8_BAR;
            }
        }
        if constexpr (ALIGN_EPI) { if (wr == 0) PG8_BAR; }
        if constexpr (!Epi::AFTER_DRAIN) { E(acc, cur, wr, wc, fr, fq); S.done(cur); }
        if (!has_next) break;
#pragma unroll
        for (int a = 0; a < 2; ++a)
#pragma unroll
            for (int b = 0; b < 2; ++b)
#pragma unroll
                for (int m = 0; m < 4; ++m)
#pragma unroll
                    for (int n = 0; n < 2; ++n) acc[a][b][m][n] = (f32x4){0.f, 0.f, 0.f, 0.f};
        cur = nxt; cA = nA; cB = nB; ++ui;
        if constexpr (ALIGN_EPI) { if (wr == 1) PG8_BAR; }
    }
    PG8_WAIT_V(0);
    if constexpr (!ALIGN_EPI) { if (wr == 0) PG8_BAR; }
    PG8_BAR;
    if constexpr (Epi::AFTER_DRAIN) { E.fused(acc, cur, wr, wc, fr, fq, lds, wid, lane); S.done(cur); }
#undef PG8_SA
#undef PG8_SB
#undef PG8_STAGE
#undef PG8_LDA
#undef PG8_LDB
#undef PG8_MMA
#undef PG8_WAIT_V
#undef PG8_WAIT_L
#undef PG8_BAR
#undef PG8_SCHED
}
}

using pg8::bf16_t; using pg8::bf16x8; using pg8::f32x4; using pg8::u32x4;
typedef float f32x16 __attribute__((ext_vector_type(16)));
typedef unsigned u32x2 __attribute__((ext_vector_type(2)));
typedef float f32x2_t __attribute__((ext_vector_type(2)));
typedef __bf16 bf16x2_t __attribute__((ext_vector_type(2)));
#define LAS __attribute__((address_space(3)))
#define DI __device__ __forceinline__

constexpr int DM = 1024, NB = 8, SEQ = 2048, MT = NB * SEQ, NMEM = 256, MMEM = NB * NMEM, TOKW = 768, DFF = 2816;
constexpr float EPS = 1e-6f, LOG2E = 1.4426950408889634f, QSCALE = 0.125f * 1.4426950408889634f;
constexpr int NWAVES = 8, NTHREADS = 512;
#define REP_KIND -1
#define REP_LAYERS 0xF
constexpr int LDS_BYTES = 148480;

constexpr size_t KiB = 1024, MiB = 1024 * 1024;
constexpr size_t WS_SSQ = 226 * MiB, WS_SSQM = 235 * MiB;
constexpr size_t WS_BAR = 0, BAR_ZERO_BYTES = 32 * KiB;
constexpr size_t WS_ABAR = 1 * MiB, WS_BBT = 1 * MiB + 64 * KiB, WS_CT = 1 * MiB + 448 * KiB;
constexpr size_t WS_MEMK = 2 * MiB, WS_MEMVT = 6 * MiB, WS_XB = 10 * MiB;
constexpr size_t WS_Z = 42 * MiB, WS_CAT = 46 * MiB, WS_HSSM = 50 * MiB, WS_HID = 42 * MiB, Z_GAP = 7 * MiB, CAT_GAP = 7 * MiB, HS_GAP = 8 * MiB;
constexpr size_t WS_WMEMKV = 130 * MiB, WS_MEMB = 134 * MiB, WS_KD = 130 * MiB, WS_VT = 154 * MiB;
constexpr size_t WS_WKV = 184 * MiB, WS_END = 236 * MiB;
__host__ __device__ constexpr size_t w_in_off(int l)  { return l == 0 ? 138 * MiB : l == 1 ? 140 * MiB : l == 2 ? 182 * MiB : 187 * MiB; }
__host__ __device__ constexpr size_t w_out_off(int l) { return l == 0 ? 142 * MiB : l == 1 ? 144 * MiB : l == 2 ? 189 * MiB : 191 * MiB; }
__host__ __device__ constexpr size_t w_glu_off(int i) { return i == 0 ? 146 * MiB : 147 * MiB + 128 * KiB; }
__host__ __device__ constexpr size_t w_gu_off(int l)  { return l == 0 ? 148 * MiB + 256 * KiB : l == 1 ? 159 * MiB + 256 * KiB : l == 2 ? 193 * MiB : 204 * MiB; }
__host__ __device__ constexpr size_t w_d_off(int l)   { return l == 0 ? 170 * MiB + 256 * KiB : l == 1 ? 175 * MiB + 768 * KiB : l == 2 ? 215 * MiB : 220 * MiB + 512 * KiB; }

enum { I_X = 0, I_MEM, I_NMIX, I_NFFN, I_NMEM, I_WIN, I_WOUT, I_MWK, I_MWV, I_MQN, I_MKN, I_FG, I_FU, I_FD,
       I_ARE, I_AIM, I_LDT, I_BRE, I_BIM, I_CRE, I_CIM, I_SD, I_WGLU, I_KVN, I_DWK, I_DWV, I_DKN, I_DQN, I_LQ1, I_LK1, I_LQ2, I_LK2, I_SUBN, N_IN };

struct Args { const float* in[N_IN]; float* out; unsigned char* ws; double dc0, dc1, dc2; int ph_lo, ph_hi, ione, pad; };
typedef const __attribute__((address_space(4))) Args* ArgsP;

DI unsigned cvtpk(float lo, float hi) { f32x2_t v = {lo, hi}; bf16x2_t b = __builtin_convertvector(v, bf16x2_t); return __builtin_bit_cast(unsigned, b); }
DI float bf2f(unsigned short h) { return __uint_as_float(((unsigned)h) << 16); }
DI float bflo(unsigned w) { return __uint_as_float(w << 16); }
DI float bfhi(unsigned w) { return __uint_as_float(w & 0xffff0000u); }
DI float wave_sum(float v) {
#pragma unroll
    for (int o = 1; o < 64; o <<= 1) v += __shfl_xor(v, o);
    return v;
}
DI float wave_max(float v) {
#pragma unroll
    for (int o = 1; o < 64; o <<= 1) v = fmaxf(v, __shfl_xor(v, o));
    return v;
}
DI float fast_sigmoid(float x) { return __builtin_amdgcn_rcpf(1.0f + __builtin_amdgcn_exp2f(-x * LOG2E)); }
DI float gelu_tanh(float y) { const float t = 1.5957691216057308f * (y + 0.044715f * y * y * y); return y * fast_sigmoid(t); }
DI float row_rstd(const float* part, int fq) {
    const f32x4 p = *(const f32x4*)(part + 4 * fq);
    float s = (p[0] + p[1]) + (p[2] + p[3]);
    s += __shfl_xor(s, 16); s += __shfl_xor(s, 32);
    return rsqrtf(s * (1.0f / DM) + EPS);
}
#define MFMA32(a, b, c) __builtin_amdgcn_mfma_f32_32x32x16_bf16((a), (b), (c), 0, 0, 0)
#define MFMA16(a, b, c) __builtin_amdgcn_mfma_f32_16x16x32_bf16((a), (b), (c), 0, 0, 0)

struct Epi {
    static constexpr bool PERM = true, AFTER_DRAIN = false;
    ArgsP a; LAS unsigned char* xl; int mode, layer, sub, pad;
    template <bool F32>
    DI void res_epi(const f32x4 (&acc)[2][2][4][2], const pg8::Unit& u, int wr, int wc, int fr, int fq, int row0, int cl, unsigned char* ws, bf16_t* o0) const {
        const float* xin = a->in[I_X]; float* xout = a->out;
        float* ssq_out = (float*)(ws + WS_SSQ) + (size_t)(2 * layer + 1 + sub) * MT * 16;
        const bool last = (sub == 1 && layer == 3);
        const unsigned xb0 = (unsigned)(row0 * DM + u.pn * 256 + cl) * 4u;
        constexpr int NB = F32 ? 2 : 4;
#pragma unroll
        for (int bt = 0; bt < 8 / NB; ++bt) {
            u32x4 raw[NB][2][F32 ? 2 : 1];
#pragma unroll
            for (int mm = 0; mm < NB; ++mm)
#pragma unroll
                for (int bj = 0; bj < 2; ++bj) { const int rg = bt * NB + mm, ai = rg >> 2, m = rg & 3;
                    const unsigned off = xb0 + (unsigned)(((ai * 128 + m * 16) * DM + bj * 32) * 4);
                    if constexpr (F32) { raw[mm][bj][0] = *(const u32x4*)((const char*)xin + off); raw[mm][bj][1] = *(const u32x4*)((const char*)xin + off + 16); }
                    else raw[mm][bj][0] = *(const u32x4*)((const char*)o0 + (off >> 1)); }
#pragma unroll
            for (int mm = 0; mm < NB; ++mm) {
                const int rg = bt * NB + mm, ai = rg >> 2, m = rg & 3;
                float ss = 0.f;
#pragma unroll
                for (int bj = 0; bj < 2; ++bj) {
                    const unsigned off = xb0 + (unsigned)(((ai * 128 + m * 16) * DM + bj * 32) * 4);
                    f32x4 r0, r1;
                    if constexpr (F32) { r0 = __builtin_bit_cast(f32x4, raw[mm][bj][0]); r1 = __builtin_bit_cast(f32x4, raw[mm][bj][1]); }
                    else { const u32x4 hb = raw[mm][bj][0]; r0 = (f32x4){bflo(hb.x), bfhi(hb.x), bflo(hb.y), bfhi(hb.y)}; r1 = (f32x4){bflo(hb.z), bfhi(hb.z), bflo(hb.w), bfhi(hb.w)}; }
                    const f32x4 x0 = r0 + acc[ai][bj][m][0];
                    const f32x4 x1 = r1 + acc[ai][bj][m][1];
                    if (last) { *(f32x4*)((char*)xout + off) = x0; *(f32x4*)((char*)xout + off + 16) = x1; }
                    const f32x4 q0 = x0 * x0, q1 = x1 * x1;
                    ss += (q0[0] + q0[1]) + (q0[2] + q0[3]) + (q1[0] + q1[1]) + (q1[2] + q1[3]);
                    u32x4 w; w.x = cvtpk(x0[0], x0[1]); w.y = cvtpk(x0[2], x0[3]); w.z = cvtpk(x1[0], x1[1]); w.w = cvtpk(x1[2], x1[3]);
                    if (!last) *(u32x4*)((char*)o0 + (off >> 1)) = w;
                }
                ss += __shfl_xor(ss, 16); ss += __shfl_xor(ss, 32);
                if (fq == 0 && !last) ssq_out[(size_t)(row0 + ai * 128 + m * 16) * 16 + u.pn * 4 + wc] = ss;
            }
            asm volatile("" ::: "memory");
        }
    }
    DI void operator()(const f32x4 (&acc)[2][2][4][2], const pg8::Unit& u, int wr, int wc, int fr, int fq) const {
        const int row0 = u.pm * 256 + wr * 64 + fr;
        const int cl = wc * 64 + 8 * fq;
        unsigned char* ws = a->ws;
        const int isB = layer >= 2;
        const float* ssq = (const float*)(ws + (mode == 1 ? WS_SSQM : WS_SSQ)) + (mode == 1 ? (size_t)0 : (size_t)(2 * layer + (mode == 4 ? 1 : 0)) * MT * 16);
        bf16_t* o0 = (bf16_t*)(ws + (mode == 0 ? WS_Z + (size_t)(u.pm >> 3) * Z_GAP : mode == 1 ? WS_MEMK : mode == 2 ? WS_CAT + (size_t)(u.pm >> 3) * CAT_GAP : mode == 3 ? WS_XB : WS_HID));
        float rs8[2][4];
        if (mode == 0 || mode == 1 || mode == 4) {
            f32x4 pp[2][4];
#pragma unroll
            for (int ai = 0; ai < 2; ++ai)
#pragma unroll
                for (int m = 0; m < 4; ++m) pp[ai][m] = *(const f32x4*)((const char*)ssq + ((unsigned)(row0 * 64 + fq * 16) + (unsigned)((ai * 128 + m * 16) * 64)));
#pragma unroll
            for (int ai = 0; ai < 2; ++ai)
#pragma unroll
                for (int m = 0; m < 4; ++m) { float s = (pp[ai][m][0] + pp[ai][m][1]) + (pp[ai][m][2] + pp[ai][m][3]); s += __shfl_xor(s, 16); s += __shfl_xor(s, 32); rs8[ai][m] = rsqrtf(s * (1.0f / DM) + EPS); }
        }
        if (mode == 0 || mode == 1) {
            int kind;
            const float* gain = nullptr; float gscale = 1.f; bf16_t* dst = o0; int pitch = DM, colbase = 0;
            bf16_t* tdst = nullptr; int tpitch = 0, tcol0 = 0;
            const int pn = u.pn;
            if (mode == 0) {
                if (pn < 3) { kind = isB ? 1 : 0; gain = a->in[I_DQN] + (isB ? (layer - 2) * 64 : 0); gscale = QSCALE; colbase = pn * 256; }
                else if (pn == 3) { kind = 1; gain = a->in[I_MQN] + layer * 64; gscale = QSCALE; colbase = 768; }
                else if (pn < 7) { kind = 1; gain = a->in[I_DKN]; gscale = 1.f; dst = (bf16_t*)(ws + WS_KD); pitch = TOKW; colbase = (pn - 4) * 256; }
                else { kind = 2; const int b = (u.pm * 256) / SEQ; const int h = (pn - 7) * 2 + (wc >> 1);
                       tdst = (bf16_t*)(ws + WS_VT) + ((size_t)(b * 6 + h) * 128 + (wc & 1) * 64) * SEQ; tpitch = SEQ; tcol0 = (u.pm * 256) % SEQ + wr * 64 + fr; }
            } else {
                const int lm = pn >> 1;
                if ((pn & 1) == 0) { kind = 1; gain = a->in[I_MKN] + lm * 64; gscale = 1.f; dst = o0 + (size_t)lm * MMEM * 256; pitch = 256; colbase = 0; }
                else { kind = 2; const int b = u.pm; tdst = (bf16_t*)(ws + WS_MEMVT) + (size_t)lm * MMEM * 256 + ((size_t)(b * 4 + wc) * 64) * NMEM; tpitch = NMEM; tcol0 = wr * 64 + fr; }
            }
            if (kind != 2) {
                f32x4 gn[2][2];
#pragma unroll
                for (int bj = 0; bj < 2; ++bj)
#pragma unroll
                    for (int n = 0; n < 2; ++n) gn[bj][n] = (kind == 1) ? *(const f32x4*)(gain + bj * 32 + 8 * fq + 4 * n) * gscale : (f32x4){1.f, 1.f, 1.f, 1.f};
#pragma unroll
                for (int ai = 0; ai < 2; ++ai)
#pragma unroll
                    for (int m = 0; m < 4; ++m) {
                        const int row = row0 + ai * 128 + m * 16;
                        const float rs = rs8[ai][m];
                        f32x4 v[2][2];
                        float ss = 0.f;
#pragma unroll
                        for (int bj = 0; bj < 2; ++bj)
#pragma unroll
                            for (int n = 0; n < 2; ++n) { v[bj][n] = acc[ai][bj][m][n] * rs; const f32x4 q = v[bj][n] * v[bj][n]; ss += (q[0] + q[1]) + (q[2] + q[3]); }
                        if (kind == 1) {
                            ss += __shfl_xor(ss, 16); ss += __shfl_xor(ss, 32);
                            const float hn = rsqrtf(ss * (1.0f / 64.0f) + EPS);
#pragma unroll
                            for (int bj = 0; bj < 2; ++bj)
#pragma unroll
                                for (int n = 0; n < 2; ++n) v[bj][n] = v[bj][n] * gn[bj][n] * hn;
                        }
                        const unsigned ob = (unsigned)(row * pitch + colbase + cl) * 2u;
#pragma unroll
                        for (int bj = 0; bj < 2; ++bj) {
                            u32x4 w; w.x = cvtpk(v[bj][0][0], v[bj][0][1]); w.y = cvtpk(v[bj][0][2], v[bj][0][3]); w.z = cvtpk(v[bj][1][0], v[bj][1][1]); w.w = cvtpk(v[bj][1][2], v[bj][1][3]);
                            *(u32x4*)((char*)dst + ob + bj * 64) = w;
                        }
                        if (m & 1) asm volatile("" ::: "memory");
                    }
            } else {
                LAS unsigned char* tb = xl + (wr * 4 + wc) * 2048;
                const int tcolb = tcol0 - fr;
                const int lane_ = fq * 16 + fr;
#pragma unroll
                for (int ai = 0; ai < 2; ++ai)
#pragma unroll
                    for (int m = 0; m < 4; ++m) {
                        const float rs = rs8[ai][m];
#pragma unroll
                        for (int bj = 0; bj < 2; ++bj)
#pragma unroll
                            for (int n = 0; n < 2; ++n)
#pragma unroll
                                for (int j = 0; j < 4; ++j)
                                    *(LAS bf16_t*)(tb + (bj * 32 + 8 * fq + 4 * n + j) * 32 + fr * 2) = (bf16_t)(cvtpk(acc[ai][bj][m][n][j] * rs, 0.f) & 0xffffu);
                        asm volatile("s_waitcnt lgkmcnt(0)" ::: "memory");
#pragma unroll
                        for (int q = 0; q < 2; ++q) {
                            const int chunk = lane_ + 64 * q, e = chunk >> 1, half = chunk & 1;
                            const u32x4 tv = *(const LAS u32x4*)(tb + e * 32 + half * 16);
                            *(u32x4*)((char*)tdst + (unsigned)(e * tpitch + tcolb + ai * 128 + m * 16 + half * 8) * 2u) = tv;
                        }
                        asm volatile("s_waitcnt lgkmcnt(0)" ::: "memory");
                    }
            }
        } else if (mode == 2) {
            const bf16_t* hin = (const bf16_t*)(ws + WS_HSSM + (size_t)(u.pm >> 3) * HS_GAP);
#pragma unroll
            for (int ai = 0; ai < 2; ++ai) {
                u32x4 hw[4][2];
#pragma unroll
                for (int m = 0; m < 4; ++m)
#pragma unroll
                    for (int bj = 0; bj < 2; ++bj) hw[m][bj] = *(const u32x4*)((const char*)hin + ((unsigned)(row0 * TOKW + u.pn * 256 + cl) * 2u + (unsigned)(((ai * 128 + m * 16) * TOKW + bj * 32) * 2)));
#pragma unroll
                for (int m = 0; m < 4; ++m) {
                    const int row = row0 + ai * 128 + m * 16;
#pragma unroll
                    for (int bj = 0; bj < 2; ++bj) {
                        const int col = u.pn * 256 + cl + bj * 32;
                        const u32x4 h4 = hw[m][bj];
                        const f32x4 a0 = acc[ai][bj][m][0], a1 = acc[ai][bj][m][1];
                        u32x4 w;
                        w.x = cvtpk(bflo(h4.x) * fast_sigmoid(a0[0]), bfhi(h4.x) * fast_sigmoid(a0[1]));
                        w.y = cvtpk(bflo(h4.y) * fast_sigmoid(a0[2]), bfhi(h4.y) * fast_sigmoid(a0[3]));
                        w.z = cvtpk(bflo(h4.z) * fast_sigmoid(a1[0]), bfhi(h4.z) * fast_sigmoid(a1[1]));
                        w.w = cvtpk(bflo(h4.w) * fast_sigmoid(a1[2]), bfhi(h4.w) * fast_sigmoid(a1[3]));
                        *(u32x4*)((char*)o0 + (unsigned)(row * DM + col) * 2u) = w;
                    }
                }
                asm volatile("" ::: "memory");
            }
        } else if (mode == 3) {
            if (sub == 0 && layer == 0) res_epi<true>(acc, u, wr, wc, fr, fq, row0, cl, ws, o0);
            else res_epi<false>(acc, u, wr, wc, fr, fq, row0, cl, ws, o0);
        } else {
#pragma unroll
            for (int ai = 0; ai < 2; ++ai)
#pragma unroll
                for (int m = 0; m < 4; ++m) {
                    const int row = row0 + ai * 128 + m * 16;
                    const float rs = rs8[ai][m];
                    const float c1 = -rs * LOG2E, c2 = rs * rs;
                    float o[8];
#pragma unroll
                    for (int n = 0; n < 2; ++n)
#pragma unroll
                        for (int j = 0; j < 4; ++j) { const float ag = acc[ai][0][m][n][j], au = acc[ai][1][m][n][j];
                            const float r = __builtin_amdgcn_rcpf(1.0f + __builtin_amdgcn_exp2f(ag * c1)); o[n * 4 + j] = (ag * au) * (c2 * r); }
                    u32x4 w; w.x = cvtpk(o[0], o[1]); w.y = cvtpk(o[2], o[3]); w.z = cvtpk(o[4], o[5]); w.w = cvtpk(o[6], o[7]);
                    *(u32x4*)((char*)o0 + (unsigned)(row * DFF + u.pn * 128 + wc * 32 + 8 * fq) * 2u) = w;
                    if (m & 1) asm volatile("" ::: "memory");
                }
        }
    }
};

DI void tr_item(const float* W, int ldw, int col0, const float* gain, bf16_t* dst, int K, int k0, LAS float* scr, int lane) {
    f32x4 v[8];
    const int c4 = (lane & 7) * 4, kr = lane >> 3;
#pragma unroll
    for (int i = 0; i < 8; ++i) v[i] = *(const f32x4*)(W + (size_t)(k0 + kr + 8 * i) * ldw + col0 + c4);
    if (gain) {
#pragma unroll
        for (int i = 0; i < 8; ++i) v[i] = v[i] * gain[k0 + kr + 8 * i];
    }
#pragma unroll
    for (int i = 0; i < 8; ++i) { LAS float* s = scr + (kr + 8 * i) * 33 + c4; s[0] = v[i][0]; s[1] = v[i][1]; s[2] = v[i][2]; s[3] = v[i][3]; }
    asm volatile("s_waitcnt lgkmcnt(0)" ::: "memory");
    const int c = lane & 7;
#pragma unroll
    for (int j = 0; j < 4; ++j) { const int n = (lane >> 3) + 8 * j; const LAS float* s = scr + (8 * c) * 33 + n;
        u32x4 o; o.x = cvtpk(s[0 * 33], s[1 * 33]); o.y = cvtpk(s[2 * 33], s[3 * 33]); o.z = cvtpk(s[4 * 33], s[5 * 33]); o.w = cvtpk(s[6 * 33], s[7 * 33]);
        *(u32x4*)(dst + (size_t)n * K + k0 + 8 * c) = o; }
    asm volatile("s_waitcnt lgkmcnt(0)" ::: "memory");
}
DI int headmap_col0(int G) { const int pn = G >> 3, blk = G & 7, bj = blk >> 2, wc = blk & 3; return pn * 256 + wc * 64 + bj * 32; }

DI void sincos_d(double x, double& s, double& c, double inv2pi, double twopi_hi, double twopi_lo, int one) {
    const double k = rint(x * inv2pi);
    double r = fma(-k, twopi_hi, x); r = fma(-k, twopi_lo, r);
    const double r2 = r * r; double ts = (double)one, tc = (double)one, ssum = (double)one, csum = (double)one;
#pragma unroll
    for (int j = 1; j <= 15; ++j) { tc = -tc * r2 / (double)((2 * j - 1) * (2 * j) * one); csum += tc; ts = -ts * r2 / (double)((2 * j) * (2 * j + 1) * one); ssum += ts; }
    s = r * ssum; c = csum;
}
DI double exp_small_d(double x, int one) {
    double t = (double)one, sum = (double)one;
#pragma unroll
    for (int j = 1; j <= 18; ++j) { t = t * x / (double)(j * one); sum += t; }
    return sum;
}

constexpr int PER_LAYER = 512 + 512 + 2816 + 1408 + 256, MEMKV_AT = 5248, EXTRA_AT = 4 * PER_LAYER;
DI void conv_item(ArgsP a, unsigned char* ws, int it, LAS float* scr, int lane) {
    {
        if (it < 4 * PER_LAYER) {
            const int l = it / PER_LAYER; int r = it % PER_LAYER;
            if (r < 512) { const int kb = r >> 5, G = r & 31;
                tr_item(a->in[I_WIN] + (size_t)l * DM * DM, DM, headmap_col0(G), a->in[I_NMIX] + l * DM, (bf16_t*)(ws + w_in_off(l)) + (size_t)G * 32 * DM, DM, kb * 64, scr, lane); return; }
            r -= 512;
            if (r < 512) { const int kb = r >> 5, G = r & 31;
                tr_item(a->in[I_WOUT] + (size_t)l * DM * DM, DM, headmap_col0(G), nullptr, (bf16_t*)(ws + w_out_off(l)) + (size_t)G * 32 * DM, DM, kb * 64, scr, lane); return; }
            r -= 512;
            if (r < 2816) { const int kb = r / 176, G = r % 176; const int pn = G >> 3, blk = G & 7, bj = blk >> 2, wc = blk & 3;
                tr_item(a->in[bj ? I_FU : I_FG] + (size_t)l * DM * DFF, DFF, pn * 128 + wc * 32, a->in[I_NFFN] + l * DM, (bf16_t*)(ws + w_gu_off(l)) + (size_t)G * 32 * DM, DM, kb * 64, scr, lane); return; }
            r -= 2816;
            if (r < 1408) { const int kb = r >> 5, G = r & 31;
                tr_item(a->in[I_FD] + (size_t)l * DFF * DM, DM, headmap_col0(G), nullptr, (bf16_t*)(ws + w_d_off(l)) + (size_t)G * 32 * DFF, DFF, kb * 64, scr, lane); return; }
            r -= 1408;
            { const int kb = r >> 4, G = r & 15; const int kv = G >> 3;
              tr_item(a->in[kv ? I_MWV : I_MWK] + (size_t)l * DM * 256, 256, headmap_col0(G & 7), a->in[I_NMEM] + l * DM, (bf16_t*)(ws + WS_WMEMKV) + ((size_t)l * 512 + G * 32) * DM, DM, kb * 64, scr, lane); return; }
        }
        int r = it - 4 * PER_LAYER;
        if (r < 576) { const int i = r / 288; r %= 288; const int kb = r / 24, G = r % 24;
            tr_item(a->in[I_WGLU] + (size_t)i * TOKW * TOKW, TOKW, headmap_col0(G), nullptr, (bf16_t*)(ws + w_glu_off(i)) + (size_t)G * 32 * TOKW, TOKW, kb * 64, scr, lane); return; }
        r -= 576;
        { const int kb = r / 48, G = r % 48; const int kv = G / 24, Gl = G % 24;
          tr_item(a->in[kv ? I_DWV : I_DWK], TOKW, headmap_col0(Gl), a->in[I_KVN], (bf16_t*)(ws + WS_WKV) + (size_t)G * 32 * DM, DM, kb * 64, scr, lane); }
    }
}
DI int n_layer_items(int layer) { return MEMKV_AT + (layer < 2 ? 288 : layer == 2 ? 768 : 0); }
DI void conv_layer(ArgsP a, LAS unsigned char* lds, int layer, int k_lo, int k_hi, int gw, int NGW) {
    int tid = tidx();
    const int lane = tid & 63, wave = __builtin_amdgcn_readfirstlane(tid >> 6);
    LAS float* scr = (LAS float*)(lds + wave * 8448);
    unsigned char* ws = a->ws;
    const int n = n_layer_items(layer) < k_hi ? n_layer_items(layer) : k_hi;
    for (int k = k_lo + gw; k < n; k += NGW) {
        const int it = k < MEMKV_AT ? layer * PER_LAYER + k : (layer < 2 ? EXTRA_AT + layer * 288 + (k - MEMKV_AT) : EXTRA_AT + 576 + (k - MEMKV_AT));
        conv_item(a, ws, it, scr, lane);
    }
}
DI void prologue(ArgsP a, LAS unsigned char* lds) {
    int tid = tidx(); asm volatile("" : "+v"(tid));
    const int lane = tid & 63, wave = __builtin_amdgcn_readfirstlane(tid >> 6);
    const int gw = blockIdx.x * NWAVES + wave, NGW = gridDim.x * NWAVES;
    unsigned char* ws = a->ws;
    LAS float* scr = (LAS float*)(lds + wave * 8448);
    conv_layer(a, lds, 0, 0, 512, gw, NGW);
    for (int k = gw; k < 4 * 256; k += NGW) conv_item(a, ws, (k >> 8) * PER_LAYER + MEMKV_AT + (k & 255), scr, lane);
    for (int m = gw; m < MT + MMEM; m += NGW) {
        const bool ismem = m >= MT; const int row = ismem ? m - MT : m;
        const float* src = (ismem ? a->in[I_MEM] : a->in[I_X]) + (size_t)row * DM;
        bf16_t* dstb = (bf16_t*)(ws + (ismem ? WS_MEMB : WS_XB)) + (size_t)row * DM;
        float ss = 0.f;
#pragma unroll
        for (int j = 0; j < 4; ++j) { const f32x4 v = *(const f32x4*)(src + 4 * lane + 256 * j); ss += (v[0] * v[0] + v[1] * v[1]) + (v[2] * v[2] + v[3] * v[3]);
            u32x2 w; w.x = cvtpk(v[0], v[1]); w.y = cvtpk(v[2], v[3]); *(u32x2*)(dstb + 4 * lane + 256 * j) = w; }
        ss = wave_sum(ss);
        if (lane < 16) ((float*)(ws + (ismem ? WS_SSQM : WS_SSQ)))[(size_t)row * 16 + lane] = lane == 0 ? ss : 0.f;
    }
    for (int idx = blockIdx.x * NTHREADS + tid; idx < 2 * 48 * 64; idx += gridDim.x * NTHREADS) {
        const int n = idx & 63, gi = idx >> 6;
        const double are = (double)a->in[I_ARE][idx], aim = (double)a->in[I_AIM][idx];
        const int one = a->ione;
        double dt; { double xs = (double)a->in[I_LDT][gi]; xs = xs * 0.5 * 0.5 * 0.5 * 0.5 * 0.5; dt = exp_small_d(xs, one); dt *= dt; dt *= dt; dt *= dt; dt *= dt; dt *= dt; }
        const double mag = exp_small_d(dt * are, one);
        double sn, cs; sincos_d(dt * aim, sn, cs, a->dc0, a->dc1, a->dc2, one);
        const double abr = mag * cs, abi = mag * sn;
        const double den = are * are + aim * aim, nr = abr - (double)one;
        const double cre = (nr * are + abi * aim) / den, cim = (abi * are - nr * aim) / den;
        float* ab = (float*)(ws + WS_ABAR) + (size_t)idx * 2; ab[0] = (float)abr; ab[1] = (float)abi;
        bf16_t* bbt = (bf16_t*)(ws + WS_BBT); bf16_t* ct = (bf16_t*)(ws + WS_CT);
#pragma unroll 4
        for (int p = 0; p < 16; ++p) {
            const double bre = (double)a->in[I_BRE][(size_t)idx * 16 + p], bim = (double)a->in[I_BIM][(size_t)idx * 16 + p];
            const float vre = (float)(cre * bre - cim * bim), vim = (float)(cre * bim + cim * bre);
            bbt[(((size_t)gi * 2 + 0) * 64 + n) * 16 + p] = (bf16_t)(cvtpk(vre, 0.f) & 0xffffu);
            bbt[(((size_t)gi * 2 + 1) * 64 + n) * 16 + p] = (bf16_t)(cvtpk(vim, 0.f) & 0xffffu);
            const float c_re = a->in[I_CRE][((size_t)gi * 16 + p) * 64 + n], c_im = a->in[I_CIM][((size_t)gi * 16 + p) * 64 + n];
            *(unsigned*)(ct + ((size_t)gi * 16 + p) * 128 + 2 * n) = cvtpk(c_re, -c_im);
        }
    }
}

DI void ssm_scan32(f32x16 (&d)[2][2], float are, float aim, float& sre, float& sim) {
#pragma unroll
    for (int a4 = 0; a4 < 4; ++a4)
#pragma unroll
        for (int cc = 0; cc < 2; ++cc)
#pragma unroll
            for (int bb = 0; bb < 4; ++bb) {
                const float bre = d[0][cc][4 * a4 + bb], bim = d[1][cc][4 * a4 + bb];
                const float nre = fmaf(are, sre, fmaf(-aim, sim, bre)), nim = fmaf(are, sim, fmaf(aim, sre, bim));
                sre = nre; sim = nim;
            }
}
DI void ssm_bu(f32x16 (&d)[2][2], const bf16x8 uf, const bf16x8 (&bq)[2][2]) {
    f32x16 zero;
#pragma unroll
    for (int i = 0; i < 16; ++i) zero[i] = 0.f;
#pragma unroll
    for (int c = 0; c < 2; ++c)
#pragma unroll
        for (int nb = 0; nb < 2; ++nb) d[c][nb] = MFMA32(uf, bq[c][nb], zero);
#pragma unroll
    for (int c = 0; c < 2; ++c)
#pragma unroll
        for (int i = 0; i < 16; ++i) {
            auto rr = __builtin_amdgcn_permlane32_swap(__float_as_uint(d[c][0][i]), __float_as_uint(d[c][1][i]), false, false);
            d[c][0][i] = __uint_as_float(rr[0]); d[c][1][i] = __uint_as_float(rr[1]);
        }
}
DI void ssm_unit(LAS unsigned char* lds, int li, int b, int g, const bf16_t* Z, bf16_t* HS, const float* abar_t, const bf16_t* bbt, const bf16_t* ct, const float* dskip) {
    int tid = tidx(); asm volatile("" : "+v"(tid));
    const int lane = tid & 63, wid = __builtin_amdgcn_readfirstlane(tid >> 6), r = lane & 31, hl = lane >> 5, p16 = lane & 15, quad = lane >> 4;
    const int gi = li * 48 + g;
    const float are = abar_t[((size_t)gi * 64 + lane) * 2], aim = abar_t[((size_t)gi * 64 + lane) * 2 + 1];
    bf16x8 bq[2][2];
#pragma unroll
    for (int c = 0; c < 2; ++c)
#pragma unroll
        for (int nb = 0; nb < 2; ++nb) bq[c][nb] = *(const bf16x8*)(bbt + (((size_t)gi * 2 + c) * 64 + nb * 32 + r) * 16 + 8 * hl);
    const size_t tok0 = (size_t)b * SEQ + 256 * wid;
    float sre = 0.f, sim = 0.f;
    LAS unsigned char* ub = lds + 8 * 8704 + 4096 + wid * 8192;
    {
        bf16x8 ufa[8];
#pragma unroll
        for (int blk = 0; blk < 8; ++blk) ufa[blk] = *(const bf16x8*)(Z + (tok0 + 32 * blk + r) * DM + 16 * g + 8 * hl);
#pragma unroll
        for (int blk = 0; blk < 8; ++blk) *(LAS bf16x8*)(ub + (32 * blk + r) * 32 + hl * 16) = ufa[blk];
    }
    asm volatile("s_waitcnt lgkmcnt(0)" ::: "memory");
    for (int blk = 0; blk < 8; ++blk) {
        const bf16x8 uf = *(const LAS bf16x8*)(ub + (32 * blk + r) * 32 + hl * 16);
        f32x16 d[2][2]; ssm_bu(d, uf, bq);
        ssm_scan32(d, are, aim, sre, sim);
    }
    LAS float* ex = (LAS float*)(lds + 8 * 8704);
    ex[(wid * 64 + lane) * 2] = sre; ex[(wid * 64 + lane) * 2 + 1] = sim;
    __syncthreads();
    float pre = are, pim = aim;
#pragma unroll
    for (int i = 0; i < 8; ++i) { const float nr = pre * pre - pim * pim, ni = 2.f * pre * pim; pre = nr; pim = ni; }
    sre = 0.f; sim = 0.f;
    for (int i = 0; i < wid; ++i) { const float ere = ex[(i * 64 + lane) * 2], eim = ex[(i * 64 + lane) * 2 + 1];
        const float nre = fmaf(pre, sre, fmaf(-pim, sim, ere)), nim = fmaf(pre, sim, fmaf(pim, sre, eim)); sre = nre; sim = nim; }
    bf16x8 cf[4];
#pragma unroll
    for (int ks = 0; ks < 4; ++ks) cf[ks] = *(const bf16x8*)(ct + ((size_t)gi * 16 + p16) * 128 + 32 * ks + 8 * quad);
    const float dsk = dskip[16 * g + p16];
    LAS unsigned char* sb = lds + wid * 8704;
    for (int blk = 0; blk < 8; ++blk) {
        const bf16x8 uf = *(const LAS bf16x8*)(ub + (32 * blk + r) * 32 + hl * 16);
        f32x16 d[2][2]; ssm_bu(d, uf, bq);
#pragma unroll
        for (int a4 = 0; a4 < 4; ++a4)
#pragma unroll
            for (int cc = 0; cc < 2; ++cc)
#pragma unroll
                for (int bb = 0; bb < 4; ++bb) {
                    const float bre = d[0][cc][4 * a4 + bb], bim = d[1][cc][4 * a4 + bb];
                    const float nre = fmaf(are, sre, fmaf(-aim, sim, bre)), nim = fmaf(are, sim, fmaf(aim, sre, bim));
                    sre = nre; sim = nim;
                    *(LAS unsigned*)(sb + (8 * a4 + 4 * cc + bb) * 272 + lane * 4) = cvtpk(sre, sim);
                }
        asm volatile("s_waitcnt lgkmcnt(0)" ::: "memory");
#pragma unroll
        for (int mb = 0; mb < 2; ++mb) {
            f32x4 y = {0.f, 0.f, 0.f, 0.f};
#pragma unroll
            for (int ks = 0; ks < 4; ++ks) { const bf16x8 af = *(const LAS bf16x8*)(sb + (16 * mb + p16) * 272 + 64 * ks + 16 * quad); y = MFMA16(af, cf[ks], y); }
#pragma unroll
            for (int j = 0; j < 4; ++j) {
                LAS bf16_t* up1 = (LAS bf16_t*)(ub + (32 * blk + 16 * mb + 4 * quad + j) * 32 + p16 * 2);
                const float uu = bf2f(*up1);
                const float hh = gelu_tanh(y[j] + dsk * uu);
                *up1 = (bf16_t)(cvtpk(hh, 0.f) & 0xffffu);
            }
        }
        asm volatile("s_waitcnt lgkmcnt(0)" ::: "memory");
        {
            const u32x4 hv = *(const LAS u32x4*)(ub + (32 * blk + (lane >> 1)) * 32 + (lane & 1) * 16);
            *(u32x4*)(HS + (tok0 + 32 * blk + (lane >> 1)) * TOKW + 16 * g + 8 * (lane & 1)) = hv;
        }
        asm volatile("s_waitcnt lgkmcnt(0)" ::: "memory");
    }
    __syncthreads();
}

template <int NC, int EB, bool BOUND>
DI void attn_core(LAS unsigned char* lds, const bf16_t* Q0, const bf16_t* Q1, int qpitch, const bf16_t* K0, const bf16_t* K1, int kpitch,
                  const bf16_t* Vt, int vpitch, int NT, int nvis, float negM, f32x16 (&o)[NC][EB], float (&l)[NC]) {
    int tid = tidx(); asm volatile("" : "+v"(tid));
    const int lane = tid & 63, wid = __builtin_amdgcn_readfirstlane(tid >> 6), r = lane & 31, hl = lane >> 5;
    constexpr int KB = 64 * 144, VB = EB * 32 * 144, BUF = NC * KB + VB, NV = EB / 2;
    constexpr int QP = NC * 128 + 16;
    LAS unsigned char* qreg = lds + 2 * BUF + wid * (32 * QP);
#pragma unroll
    for (int c = 0; c < NC; ++c)
#pragma unroll
        for (int i = 0; i < 4; ++i) { const int idx = lane + 64 * i;
            *(LAS u32x4*)(qreg + (idx >> 3) * QP + c * 128 + (idx & 7) * 16) = *(const u32x4*)((const char*)((c ? Q1 : Q0) + (size_t)(32 * wid) * qpitch) + (unsigned)(((idx >> 3) * qpitch + (idx & 7) * 8) * 2)); }
    const LAS unsigned char* qrd = qreg + r * QP + hl * 16;
#pragma unroll
    for (int c = 0; c < NC; ++c) { l[c] = 0.f;
#pragma unroll
        for (int eb = 0; eb < EB; ++eb)
#pragma unroll
            for (int i = 0; i < 16; ++i) o[c][eb][i] = 0.f; }
    const int krow = tid >> 3, kch = tid & 7;
    u32x4 sk[NC], sv[NV];
    const unsigned kvoff = (unsigned)(krow * kpitch + kch * 8) * 2u;
    unsigned vvoff[NV];
#pragma unroll
    for (int i = 0; i < NV; ++i) { const int idx = tid + 512 * i; vvoff[i] = (unsigned)((idx >> 3) * vpitch + (idx & 7) * 8) * 2u; }
#define ATT_GLOAD(kt) do { _Pragma("unroll") for (int c = 0; c < NC; ++c) sk[c] = *(const u32x4*)((const char*)((c ? K1 : K0) + (size_t)(kt) * 64 * kpitch) + kvoff); \
        _Pragma("unroll") for (int i = 0; i < NV; ++i) sv[i] = *(const u32x4*)((const char*)(Vt + (kt) * 64) + vvoff[i]); } while (0)
#define ATT_LSTORE(bi) do { LAS unsigned char* Bw = lds + (bi) * BUF; _Pragma("unroll") for (int c = 0; c < NC; ++c) *(LAS u32x4*)(Bw + c * KB + krow * 144 + kch * 16) = sk[c]; \
        _Pragma("unroll") for (int i = 0; i < NV; ++i) { const int idx = tid + 512 * i; *(LAS u32x4*)(Bw + NC * KB + (idx >> 3) * 144 + (idx & 7) * 16) = sv[i]; } } while (0)
    ATT_GLOAD(0); ATT_LSTORE(0); __syncthreads();
    const int pr = (r & ~12) | ((r & 4) << 1) | ((r & 8) >> 1);
#pragma nounroll
    for (int kt = 0; kt < NT; ++kt) {
        if (kt + 1 < NT) ATT_GLOAD(kt + 1);
        if (kt < nvis) {
            const LAS unsigned char* B = lds + (kt & 1) * BUF;
#pragma unroll
            for (int kb = 0; kb < 2; ++kb) {
                bf16x8 pf[NC][2];
#pragma unroll
                for (int c = 0; c < NC; ++c) {
                    f32x16 s;
#pragma unroll
                    for (int i = 0; i < 16; ++i) s[i] = 0.f;
#pragma unroll
                    for (int ds = 0; ds < 4; ++ds) { const bf16x8 kf = *(const LAS bf16x8*)(B + c * KB + (32 * kb + pr) * 144 + (16 * ds + 8 * hl) * 2); const bf16x8 qv = *(const LAS bf16x8*)(qrd + c * 128 + ds * 32); s = MFMA32(kf, qv, s); }
                    if (BOUND) {
#pragma unroll
                        for (int i = 0; i < 16; ++i) s[i] = __builtin_amdgcn_exp2f(s[i] + negM);
                    } else {
#pragma unroll
                        for (int i = 0; i < 16; ++i) s[i] = __builtin_amdgcn_exp2f(s[i]);
                    }
                    {
                        float ls;
                        asm("s_nop 0\n\tv_add_f32_e32 %0, %1, %2\n\tv_add_f32_e32 %0, %0, %3\n\tv_add_f32_e32 %0, %0, %4\n\tv_add_f32_e32 %0, %0, %5\n\tv_add_f32_e32 %0, %0, %6\n\tv_add_f32_e32 %0, %0, %7\n\tv_add_f32_e32 %0, %0, %8\n\tv_add_f32_e32 %0, %0, %9\n\t"
                            "v_add_f32_e32 %0, %0, %10\n\tv_add_f32_e32 %0, %0, %11\n\tv_add_f32_e32 %0, %0, %12\n\tv_add_f32_e32 %0, %0, %13\n\tv_add_f32_e32 %0, %0, %14\n\tv_add_f32_e32 %0, %0, %15\n\tv_add_f32_e32 %0, %0, %16"
                            : "=&v"(ls) : "v"(s[0]), "v"(s[1]), "v"(s[2]), "v"(s[3]), "v"(s[4]), "v"(s[5]), "v"(s[6]), "v"(s[7]), "v"(s[8]), "v"(s[9]), "v"(s[10]), "v"(s[11]), "v"(s[12]), "v"(s[13]), "v"(s[14]), "v"(s[15]));
                        l[c] += ls;
                    }
                    u32x4 w0, w1;
                    w0.x = cvtpk(s[0], s[1]); w0.y = cvtpk(s[2], s[3]); w0.z = cvtpk(s[4], s[5]); w0.w = cvtpk(s[6], s[7]);
                    w1.x = cvtpk(s[8], s[9]); w1.y = cvtpk(s[10], s[11]); w1.z = cvtpk(s[12], s[13]); w1.w = cvtpk(s[14], s[15]);
                    pf[c][0] = __builtin_bit_cast(bf16x8, w0); pf[c][1] = __builtin_bit_cast(bf16x8, w1);
                    __builtin_amdgcn_sched_barrier(0);
                }
#pragma unroll
                for (int eb = 0; eb < EB; ++eb)
#pragma unroll
                    for (int s2 = 0; s2 < 2; ++s2) {
                        const bf16x8 vf = *(const LAS bf16x8*)(B + NC * KB + (32 * eb + r) * 144 + (32 * kb + 16 * s2 + 8 * hl) * 2);
#pragma unroll
                        for (int c = 0; c < NC; ++c) o[c][eb] = MFMA32(vf, pf[c][s2], o[c][eb]);
                        __builtin_amdgcn_sched_barrier(0);
                    }
            }
        }
        if (kt + 1 < NT) ATT_LSTORE((kt + 1) & 1);
        __syncthreads();
    }
#undef ATT_GLOAD
#undef ATT_LSTORE
}

DI void diff_unit(LAS unsigned char* lds, ArgsP a, int j, int layer, int bh, int qb) {
    const int tid = tidx(), lane = tid & 63, wid = __builtin_amdgcn_readfirstlane(tid >> 6);
    const int b = bh / 6, h = bh % 6;
    unsigned char* ws = a->ws;
    const bf16_t* Z = (const bf16_t*)(ws + WS_Z + (size_t)b * Z_GAP); const bf16_t* KD = (const bf16_t*)(ws + WS_KD); const bf16_t* VT = (const bf16_t*)(ws + WS_VT);
    bf16_t* CAT = (bf16_t*)(ws + WS_CAT + (size_t)b * CAT_GAP);
    const float gqk = fabsf(a->in[I_DQN][j * 64 + lane] * a->in[I_DKN][lane]);
    const float negM = -8.0f * LOG2E * wave_max(gqk);
    const float s1 = wave_sum(a->in[I_LQ1][j * 64 + lane] * a->in[I_LK1][j * 64 + lane]), s2 = wave_sum(a->in[I_LQ2][j * 64 + lane] * a->in[I_LK2][j * 64 + lane]);
    const float lambda_init = 0.8f - 0.6f * expf(-0.3f * (float)layer);
    const float lam = expf(s1) - expf(s2) + lambda_init;
    f32x16 o[2][4]; float l[2];
    const bf16_t* Q0 = Z + ((size_t)b * SEQ + 256 * qb) * DM + h * 64;
    const bf16_t* K0 = KD + ((size_t)b * SEQ) * TOKW + h * 64;
    if (negM < -64.0f) attn_core<2, 4, true>(lds, Q0, Q0 + 384, DM, K0, K0 + 384, TOKW, VT + ((size_t)(b * 6 + h) * 128) * SEQ, SEQ, 4 * qb + 4, 4 * qb + (wid >> 1) + 1, negM, o, l);
    else attn_core<2, 4, false>(lds, Q0, Q0 + 384, DM, K0, K0 + 384, TOKW, VT + ((size_t)(b * 6 + h) * 128) * SEQ, SEQ, 4 * qb + 4, 4 * qb + (wid >> 1) + 1, 0.f, o, l);
    int lane2 = tidx() & 63; asm volatile("" : "+v"(lane2));
    const int r = lane2 & 31, hl = lane2 >> 5;
    const float l0 = l[0] + __shfl_xor(l[0], 32), l1 = l[1] + __shfl_xor(l[1], 32);
    const float inv0 = 1.0f / l0, inv1 = lam / l1;
    float ss = 0.f;
#pragma unroll
    for (int eb = 0; eb < 4; ++eb)
#pragma unroll
        for (int i = 0; i < 16; ++i) { const float v = o[0][eb][i] * inv0 - o[1][eb][i] * inv1; o[0][eb][i] = v; ss += v * v; }
    ss += __shfl_xor(ss, 32);
    const float rn = rsqrtf(ss * (1.0f / 128.0f) + EPS) * (1.0f - lambda_init);
    const float* sg = a->in[I_SUBN] + j * 128;
    char* opb = (char*)(CAT + ((size_t)b * SEQ + 256 * qb + 32 * wid) * DM + h * 128);
    const unsigned ooff = (unsigned)(r * DM + 4 * hl) * 2u;
#pragma unroll
    for (int eb = 0; eb < 4; ++eb)
#pragma unroll
        for (int a4 = 0; a4 < 4; ++a4) {
            const f32x4 g = *(const f32x4*)((const char*)(sg + 32 * eb + 8 * a4) + (unsigned)(hl * 16));
            u32x2 w; w.x = cvtpk(o[0][eb][4 * a4] * rn * g[0], o[0][eb][4 * a4 + 1] * rn * g[1]); w.y = cvtpk(o[0][eb][4 * a4 + 2] * rn * g[2], o[0][eb][4 * a4 + 3] * rn * g[3]);
            *(u32x2*)(opb + (32 * eb + 8 * a4) * 2 + ooff) = w;
        }
}
DI void mem_unit(LAS unsigned char* lds, ArgsP a, int layer, int unit) {
    const int tid = tidx(), lane = tid & 63, wid = __builtin_amdgcn_readfirstlane(tid >> 6);
    const int b = unit >> 5, hm = (unit >> 3) & 3, qb = unit & 7;
    unsigned char* ws = a->ws;
    const bf16_t* Z = (const bf16_t*)(ws + WS_Z + (size_t)b * Z_GAP); bf16_t* CAT = (bf16_t*)(ws + WS_CAT + (size_t)b * CAT_GAP);
    const bf16_t* MK = (const bf16_t*)(ws + WS_MEMK) + (size_t)layer * MMEM * 256; const bf16_t* MV = (const bf16_t*)(ws + WS_MEMVT) + (size_t)layer * MMEM * 256;
    const float gqk = fabsf(a->in[I_MQN][layer * 64 + lane] * a->in[I_MKN][layer * 64 + lane]);
    const float negM = -8.0f * LOG2E * wave_max(gqk);
    f32x16 o[1][2]; float l[1];
    const bf16_t* Q0 = Z + ((size_t)b * SEQ + 256 * qb) * DM + 768 + hm * 64;
    const bf16_t* K0 = MK + ((size_t)b * NMEM) * 256 + hm * 64;
    if (negM < -64.0f) attn_core<1, 2, true>(lds, Q0, Q0, DM, K0, K0, 256, MV + ((size_t)(b * 4 + hm) * 64) * NMEM, NMEM, 4, 4, negM, o, l);
    else attn_core<1, 2, false>(lds, Q0, Q0, DM, K0, K0, 256, MV + ((size_t)(b * 4 + hm) * 64) * NMEM, NMEM, 4, 4, 0.f, o, l);
    int lane2 = tidx() & 63; asm volatile("" : "+v"(lane2));
    const int r = lane2 & 31, hl = lane2 >> 5;
    const float inv = 1.0f / (l[0] + __shfl_xor(l[0], 32));
    char* opb = (char*)(CAT + ((size_t)b * SEQ + 256 * qb + 32 * wid) * DM + 768 + hm * 64);
    const unsigned ooff = (unsigned)(r * DM + 4 * hl) * 2u;
#pragma unroll
    for (int eb = 0; eb < 2; ++eb)
#pragma unroll
        for (int a4 = 0; a4 < 4; ++a4) {
            u32x2 w; w.x = cvtpk(o[0][eb][4 * a4] * inv, o[0][eb][4 * a4 + 1] * inv); w.y = cvtpk(o[0][eb][4 * a4 + 2] * inv, o[0][eb][4 * a4 + 3] * inv);
            *(u32x2*)(opb + (32 * eb + 8 * a4) * 2 + ooff) = w;
        }
}

#define XB_TMO      128
#define XB_XCNT(j)  (256  + 64 * (j))
#define XB_XSUB(j)  (1280 + 64 * (j))
#define XB_XGEN(j)  (2304 + 64 * (j))
#define XB_TOP      3328
#define XB_TOPGEN   3392
#define XCD_BAR_WORDS 3456
#define XB_SPIN_CAP (1u << 18)

__device__ __forceinline__ unsigned xb_ld(unsigned* p)              { return __hip_atomic_load(p, __ATOMIC_RELAXED, __HIP_MEMORY_SCOPE_AGENT); }
__device__ __forceinline__ unsigned xb_add(unsigned* p, unsigned v) { return __hip_atomic_fetch_add(p, v, __ATOMIC_RELAXED, __HIP_MEMORY_SCOPE_AGENT); }
__device__ __forceinline__ unsigned xb_xcc_id() { return (unsigned)__builtin_amdgcn_s_getreg((3 << 11) | 20) & 0xFu; }
#define XB_SPIN(cond, bar) do { unsigned _sp = 0; while (cond) { __builtin_amdgcn_s_sleep(1); \
    if ((++_sp & 255u) == 0u) { if (xb_ld(&(bar)[XB_TMO])) break; if (_sp > XB_SPIN_CAP) { atomicAdd(&(bar)[XB_TMO], 1u); break; } } } } while (0)

struct XcdBarrier {
    unsigned* bar; unsigned x;
    volatile LAS unsigned* st;
};

__device__ __forceinline__ XcdBarrier xcd_barrier_post(unsigned* bar, volatile LAS unsigned* st) {
    XcdBarrier b; b.bar = bar; b.x = xb_xcc_id(); b.st = st;
    if (tidx() == 0) (void)xb_add(&bar[XB_XCNT(b.x)], 1u);
    return b;
}
__device__ __forceinline__ void xcd_barrier_complete(unsigned* bar, unsigned x, unsigned& nloc, unsigned& nx) {
    const unsigned G = gridDim.x * gridDim.y * gridDim.z;
    unsigned sum, cnt, mine, sp = 0u;
    for (;;) {
        sum = 0u; cnt = 0u; mine = 0u;
#pragma unroll
        for (unsigned j = 0; j < 16; ++j) { const unsigned c = xb_ld(&bar[XB_XCNT(j)]); sum += c; cnt += (c > 0u) ? 1u : 0u; mine = (j == x) ? c : mine; }
        if (sum == G) break;
        __builtin_amdgcn_s_sleep(1);
        if ((++sp & 255u) == 0u) { if (xb_ld(&bar[XB_TMO])) break; if (sp > XB_SPIN_CAP) { atomicAdd(&bar[XB_TMO], 1u); break; } }
    }
    nloc = mine > 0u ? mine : 1u; nx = cnt > 0u ? cnt : 1u;
}

__device__ __forceinline__ void xcd_barrier(const XcdBarrier& b) {
    asm volatile("s_waitcnt vmcnt(0)" ::: "memory");
    __syncthreads();
    if (tidx() == 0) {
        unsigned* bar = b.bar;
        __builtin_amdgcn_s_waitcnt(0);
        unsigned nloc = b.st[0], nx = b.st[1];
        if (nloc == 0u) { xcd_barrier_complete(bar, b.x, nloc, nx); b.st[0] = nloc; b.st[1] = nx; }
        const unsigned old = xb_add(&bar[XB_XSUB(b.x)], 1u);
        const unsigned gen = old / nloc;
        if (old + 1u == (gen + 1u) * nloc) {
            __builtin_amdgcn_fence(__ATOMIC_RELEASE, "agent");
            asm volatile("s_waitcnt vmcnt(0)" ::: "memory");
            const unsigned og = xb_add(&bar[XB_TOP], 1u);
            const unsigned tg = og / nx;
            if (og + 1u == (tg + 1u) * nx) xb_add(&bar[XB_TOPGEN], 1u);
            else XB_SPIN(xb_ld(&bar[XB_TOPGEN]) == tg, bar);
            __builtin_amdgcn_fence(__ATOMIC_ACQUIRE, "agent");
            xb_add(&bar[XB_XGEN(b.x)], 1u);
            asm volatile("s_waitcnt vmcnt(0)" ::: "memory");
        } else {
            XB_SPIN(xb_ld(&bar[XB_XGEN(b.x)]) == gen, bar);
            __builtin_amdgcn_fence(__ATOMIC_ACQUIRE, "agent");
            asm volatile("s_waitcnt vmcnt(0)" ::: "memory");
        }
    }
    __syncthreads();
}

#define GB_SUB(g)  (4096 + 128 * (g))
#define GB_GEN(g)  (4096 + 128 * (g) + 64)
#define GB_MASK(g) (5120 + 64 * (g))
DI void group_barrier(unsigned* bar, volatile LAS unsigned* st) {
    asm volatile("s_waitcnt vmcnt(0)" ::: "memory");
    __syncthreads();
    if (tidx() == 0) {
        const unsigned g = blockIdx.x & 7u;
        unsigned fast = st[2];
        if (fast == 0u) { const unsigned m = xb_ld(&bar[GB_MASK(g)]); fast = ((m & (m - 1u)) == 0u) ? 1u : 2u; st[2] = fast; }
        if (fast != 1u) { __builtin_amdgcn_fence(__ATOMIC_RELEASE, "agent"); asm volatile("s_waitcnt vmcnt(0)" ::: "memory"); }
        const unsigned old = xb_add(&bar[GB_SUB(g)], 1u);
        const unsigned gen = old / 32u;
        if (old + 1u == (gen + 1u) * 32u) xb_add(&bar[GB_GEN(g)], 1u);
        else XB_SPIN(xb_ld(&bar[GB_GEN(g)]) == gen, bar);
        __builtin_amdgcn_fence(__ATOMIC_ACQUIRE, "agent");
        asm volatile("s_waitcnt vmcnt(0)" ::: "memory");
    }
    __syncthreads();
}

constexpr int NPH = 24;
enum { PK_PRO = 0, PK_Z, PK_MEMKV, PK_MIX, PK_GLU, PK_OUT, PK_GU, PK_DOWN };
DI void decode_phase(int ph, int& kind, int& layer) {
    if (ph == 0) { kind = PK_PRO; layer = 0; return; }
    if (ph < 8) { layer = 0; const int k = ph - 1; kind = k == 0 ? PK_Z : k == 1 ? PK_MEMKV : k == 2 ? PK_MIX : k == 3 ? PK_GLU : k == 4 ? PK_OUT : k == 5 ? PK_GU : PK_DOWN; return; }
    if (ph < 14) { layer = 1; const int k = ph - 8; kind = k == 0 ? PK_Z : k == 1 ? PK_MIX : k == 2 ? PK_GLU : k == 3 ? PK_OUT : k == 4 ? PK_GU : PK_DOWN; return; }
    layer = ph < 19 ? 2 : 3; const int k = ph - (ph < 19 ? 14 : 19); kind = k == 0 ? PK_Z : k == 1 ? PK_MIX : k == 2 ? PK_OUT : k == 3 ? PK_GU : PK_DOWN;
}

__global__ void __launch_bounds__(NTHREADS) mk_fwd(Args a_by_value) {
    extern __shared__ __attribute__((aligned(16))) unsigned char lds_raw[];
    LAS unsigned char* lds = (LAS unsigned char*)lds_raw;
    ArgsP a = (ArgsP)__builtin_amdgcn_kernarg_segment_ptr();
    const int ph_hi = a->ph_hi;
    if (ph_hi - a->ph_lo > 1) { volatile LAS unsigned* bst = (volatile LAS unsigned*)(lds + LDS_BYTES - 64); if (tidx() < 16) bst[tidx()] = 0u; __syncthreads(); (void)xcd_barrier_post((unsigned*)(a->ws + WS_BAR), bst); if (tidx() == 0) (void)__hip_atomic_fetch_or((unsigned*)(a->ws + WS_BAR) + GB_MASK(blockIdx.x & 7u), 1u << xb_xcc_id(), __ATOMIC_RELAXED, __HIP_MEMORY_SCOPE_AGENT); }
    int repeated = 0;
#pragma nounroll
    for (int ph = a->ph_lo; ph < ph_hi; ++ph) {
        asm volatile("" : "+s"(a));
        unsigned char* ws = a->ws;
        int kind, layer; decode_phase(ph, kind, layer);
        if (kind == PK_PRO) {
#ifndef NO_PRO
            prologue(a, lds);
#endif
        } else if (kind == PK_MIX) {
            const int bx = blockIdx.x & 7, jw = blockIdx.x >> 3;
            if (layer < 2) {
#ifndef NO_SSM
                for (int g = jw; g < 48; g += 32)
                    ssm_unit(lds, layer, bx, g, (const bf16_t*)(ws + WS_Z + (size_t)bx * Z_GAP), (bf16_t*)(ws + WS_HSSM + (size_t)bx * HS_GAP), (const float*)(ws + WS_ABAR), (const bf16_t*)(ws + WS_BBT), (const bf16_t*)(ws + WS_CT), a->in[I_SD] + layer * TOKW);
#endif
#ifndef NO_MEM
                if (jw >= 16) { for (int i = 0; i < 2; ++i) mem_unit(lds, a, layer, bx * 32 + 2 * (jw - 16) + i); }
#endif
            } else {
#ifndef NO_DIFF
                const int j = layer - 2;
                if (jw < 30) {
                    const int grp = jw / 6, h = jw % 6;
                    const int nun = grp < 2 ? 1 : 2;
                    for (int i = 0; i < nun; ++i) { const int qb = i == 0 ? 7 - grp : grp - 2; diff_unit(lds, a, j, layer, bx * 6 + h, qb); }
                }
                { const int m0 = jw < 6 ? 0 : jw < 30 ? (jw - 6) : 24 + 4 * (jw - 30), nm = jw < 6 ? 0 : jw < 30 ? 1 : 4;
                  for (int i = 0; i < nm; ++i) mem_unit(lds, a, layer, bx * 32 + m0 + i); }
#endif
            }
        } else {
            pg8::Gemm g; Epi E{}; E.a = a; E.layer = layer; E.xl = lds + 131072;
            if (kind == PK_Z) { g = pg8::Gemm{(const bf16_t*)(ws + WS_XB), (const bf16_t*)(ws + w_in_off(layer)), MT, layer == 2 ? 2560 : 1024, DM}; E.mode = 0; }
            else if (kind == PK_MEMKV) { g = pg8::Gemm{(const bf16_t*)(ws + WS_MEMB), (const bf16_t*)(ws + WS_WMEMKV), MMEM, 2048, DM}; E.mode = 1; }
            else if (kind == PK_GLU) { g = pg8::Gemm{(const bf16_t*)(ws + WS_HSSM), (const bf16_t*)(ws + w_glu_off(layer)), MT, TOKW, TOKW, HS_GAP}; E.mode = 2; }
            else if (kind == PK_OUT) { g = pg8::Gemm{(const bf16_t*)(ws + WS_CAT), (const bf16_t*)(ws + w_out_off(layer)), MT, DM, DM, CAT_GAP}; E.mode = 3; E.sub = 0; }
            else if (kind == PK_GU) { g = pg8::Gemm{(const bf16_t*)(ws + WS_XB), (const bf16_t*)(ws + w_gu_off(layer)), MT, 2 * DFF, DM}; E.mode = 4; }
            else { g = pg8::Gemm{(const bf16_t*)(ws + WS_HID), (const bf16_t*)(ws + w_d_off(layer)), MT, DM, DFF}; E.mode = 3; E.sub = 1; }
            pg8::StaticOrder S; S.init(g.M, g.N, (int)gridDim.x, (int)blockIdx.x);
#ifndef NO_GEMM
            pg8::gemm_phase<Epi, pg8::StaticOrder, true, true>(lds, g, S, E);
#endif
            if (kind == PK_MEMKV && blockIdx.x >= 64) conv_layer(a, lds, 0, 512, 1 << 30, ((int)blockIdx.x - 64) * NWAVES + __builtin_amdgcn_readfirstlane(tidx() >> 6), 192 * NWAVES);
            if (kind == PK_GU && layer < 3 && blockIdx.x >= 128) conv_layer(a, lds, layer + 1, 0, 1 << 30, ((int)blockIdx.x - 128) * NWAVES + __builtin_amdgcn_readfirstlane(tidx() >> 6), 128 * NWAVES);
        }
        if (ph + 1 < ph_hi && ph != 1) {
            if (ph_hi < 0) cg::this_grid().sync();
            volatile LAS unsigned* bst = (volatile LAS unsigned*)(lds + LDS_BYTES - 64);
            if (kind == PK_PRO || kind == PK_MEMKV || kind == PK_DOWN || gridDim.x != 256u) { XcdBarrier bar; bar.bar = (unsigned*)(a->ws + WS_BAR); bar.x = xb_xcc_id(); bar.st = bst; xcd_barrier(bar); }
            else group_barrier((unsigned*)(a->ws + WS_BAR), bst);
        }
        if (REP_KIND >= 0) { if (kind == REP_KIND && ((REP_LAYERS >> layer) & 1) && !repeated) { repeated = 1; --ph; } else repeated = 0; }
    }
}

extern "C" void kernel_launch(void* const* d_in, const int* in_sizes, int n_in, void* d_out, int out_size, void* d_ws, size_t ws_size, hipStream_t stream) {
    static int grid = 0;
    if (grid == 0) {
        if (n_in != N_IN || out_size != MT * DM || ws_size < WS_END) { fprintf(stderr, "kernel_launch: unexpected problem (n_in %d, out %d, ws %zu; need ws >= %zu)\n", n_in, out_size, ws_size, (size_t)WS_END); grid = -1; return; }
        if (hipFuncSetAttribute((const void*)mk_fwd, hipFuncAttributeMaxDynamicSharedMemorySize, LDS_BYTES) != hipSuccess) { fprintf(stderr, "kernel_launch: hipFuncSetAttribute failed\n"); grid = -1; return; }
        int dev = 0, cus = 0, per_cu = 0;
        hipGetDevice(&dev); hipDeviceGetAttribute(&cus, hipDeviceAttributeMultiprocessorCount, dev);
        hipOccupancyMaxActiveBlocksPerMultiprocessor(&per_cu, (const void*)mk_fwd, NTHREADS, LDS_BYTES);
        if (per_cu < 1 || cus < 256) { fprintf(stderr, "kernel_launch: occupancy %d per CU, %d CUs: need >= 1 and 256\n", per_cu, cus); grid = -1; return; }
        grid = 256;
    }
    if (grid < 0) return;
    Args a{};
    for (int i = 0; i < N_IN; ++i) a.in[i] = (const float*)d_in[i];
    a.out = (float*)d_out; a.ws = (unsigned char*)d_ws;
    a.dc0 = 0.15915494309189533577; a.dc1 = 6.283185307179586; a.dc2 = 2.4492935982947064e-16; a.ione = 1;
#if MK_MULTI
    for (int ph = 0; ph < NPH; ++ph) { a.ph_lo = ph; a.ph_hi = ph + 1; hipLaunchKernelGGL(mk_fwd, dim3(grid), dim3(NTHREADS), LDS_BYTES, stream, a); }
#else
    a.ph_lo = 0; a.ph_hi = NPH;
    if (hipMemsetAsync((char*)d_ws + WS_BAR, 0, BAR_ZERO_BYTES, stream) != hipSuccess) { fprintf(stderr, "kernel_launch: memset failed\n"); return; }
    void* args[] = {&a};
    hipError_t e = hipLaunchCooperativeKernel((const void*)mk_fwd, dim3(grid), dim3(NTHREADS), args, LDS_BYTES, stream);
    if (e != hipSuccess) fprintf(stderr, "kernel_launch: cooperative launch failed: %s\n", hipGetErrorString(e));
#endif
}
```
